# Optimizing an MI355X kernel written in HIP

```python
import jax, jax.numpy as jnp
from jax import lax
import numpy as np


D_MODEL = 2048
BATCH = 2
SEQ = 16384
DEPTH = 1

N_FOX_HEADS = 8
FOX_HEAD_DIM = D_MODEL // 16
FOX_WIDTH = N_FOX_HEADS * FOX_HEAD_DIM
N_MLSTM_HEADS = 4
MLSTM_V_DIM = D_MODEL // 8
MLSTM_QK_DIM = MLSTM_V_DIM // 2
MLSTM_WIDTH = N_MLSTM_HEADS * MLSTM_V_DIM
MLSTM_QK_WIDTH = N_MLSTM_HEADS * MLSTM_QK_DIM
MIX_WIDTH = FOX_WIDTH + MLSTM_WIDTH
CONV_WIDTH = 4
D_FF = ((8 * D_MODEL // 3 + 255) // 256) * 256
Q_BLOCK = 128
MLSTM_CHUNK = 64
N_ADA = 9
ALPHA = (2 * DEPTH) ** 0.25
BETA = (8 * DEPTH) ** -0.25
LN_EPS = 1e-5

COL_FOX_Q = 0
COL_FOX_K = COL_FOX_Q + FOX_WIDTH
COL_FOX_V = COL_FOX_K + FOX_WIDTH
COL_FOX_F = COL_FOX_V + FOX_WIDTH
COL_MLSTM_Q = COL_FOX_F + N_FOX_HEADS
COL_MLSTM_K = COL_MLSTM_Q + MLSTM_QK_WIDTH
COL_MLSTM_V = COL_MLSTM_K + MLSTM_QK_WIDTH
COL_MLSTM_I = COL_MLSTM_V + MLSTM_WIDTH
COL_MLSTM_F = COL_MLSTM_I + N_MLSTM_HEADS
COL_MLSTM_O = COL_MLSTM_F + N_MLSTM_HEADS
IN_WIDTH = COL_MLSTM_O + MLSTM_WIDTH

kernel_name = 'hymba_fox_mlstm_macaron_deepnorm_adaln'


def _layernorm(x, g=None, b=None):
    xf = x.astype(jnp.float32)
    mu = xf.mean(-1, keepdims=True)
    var = jnp.square(xf - mu).mean(-1, keepdims=True)
    y = (xf - mu) * lax.rsqrt(var + LN_EPS)
    if g is not None:
        y = y * g + b
    return y.astype(x.dtype)


def _modulate(x, shift, scale):
    return _layernorm(x) * (1 + scale) + shift


def _swiglu(h, w_in, w_out):
    gate, up = jnp.split(h @ w_in, 2, axis=-1)
    return (jax.nn.silu(gate) * up) @ w_out


def _fox_attention(q, k, v, log_f):
    B, S = q.shape[:2]
    scale = FOX_HEAD_DIM ** -0.5
    qh = jnp.swapaxes(q, 1, 2)
    kh = jnp.swapaxes(k, 1, 2)
    vh = jnp.swapaxes(v, 1, 2)
    F = jnp.cumsum(jnp.swapaxes(log_f, 1, 2), axis=-1)
    key_pos = jnp.arange(S)

    def block(i):
        start = i * Q_BLOCK
        qb = lax.dynamic_slice_in_dim(qh, start, Q_BLOCK, axis=2)
        Fq = lax.dynamic_slice_in_dim(F, start, Q_BLOCK, axis=2)
        logits = (jnp.einsum('bhqd,bhkd->bhqk', qb, kh).astype(jnp.float32) * scale
                  + Fq[..., :, None] - F[..., None, :])
        q_pos = start + jnp.arange(Q_BLOCK)
        mask = key_pos[None, :] <= q_pos[:, None]
        p = jax.nn.softmax(jnp.where(mask, logits, -jnp.inf), axis=-1).astype(vh.dtype)
        return jnp.einsum('bhqk,bhkd->bhqd', p, vh)

    out = lax.map(block, jnp.arange(S // Q_BLOCK))
    return jnp.transpose(out, (1, 0, 3, 2, 4)).reshape(B, S, FOX_WIDTH)


def _causal_dwconv(u, w, b):
    S = u.shape[1]
    up = jnp.pad(u, ((0, 0), (CONV_WIDTH - 1, 0), (0, 0)))
    return sum(w[j] * up[:, j:j + S] for j in range(CONV_WIDTH)) + b


def _mlstm(q, k, v, i_pre, log_f):
    B, S, H, dk = q.shape
    dv = v.shape[-1]
    L = MLSTM_CHUNK
    nc = S // L

    def chunks4(a):
        return jnp.transpose(a.reshape(B, nc, L, H, a.shape[-1]), (1, 0, 3, 2, 4))

    def chunks3(a):
        return jnp.transpose(a.reshape(B, nc, L, H), (1, 0, 3, 2))

    causal = jnp.tril(jnp.ones((L, L), dtype=bool))

    def step(carry, xs):
        C, n, m = carry
        qc, kc, vc, ic, fc = xs
        b = jnp.cumsum(fc, axis=-1)
        dlog = jnp.where(causal, b[..., :, None] - b[..., None, :] + ic[..., None, :], -jnp.inf)
        m_inter = b + m[..., None]
        m_t = jnp.maximum(m_inter, dlog.max(-1))
        s = jnp.einsum('bhtd,bhsd->bhts', qc, kc).astype(jnp.float32) * jnp.exp(dlog - m_t[..., None])
        inter = jnp.exp(m_inter - m_t)
        num = (inter[..., None] * jnp.einsum('bhtd,bhdv->bhtv', qc, C)
               + jnp.einsum('bhts,bhsv->bhtv', s, vc))
        den = inter * jnp.einsum('bhtd,bhd->bht', qc, n) + s.sum(-1)
        h = num / jnp.maximum(jnp.abs(den), jnp.exp(-m_t))[..., None]
        bL = b[..., -1]
        wlog = bL[..., None] - b + ic
        m_new = jnp.maximum(bL + m, wlog.max(-1))
        decay = jnp.exp(bL + m - m_new)
        wk = kc * jnp.exp(wlog - m_new[..., None])[..., None]
        C_new = decay[..., None, None] * C + jnp.einsum('bhsd,bhsv->bhdv', wk, vc)
        n_new = decay[..., None] * n + wk.sum(2)
        return (C_new, n_new, m_new), h

    init = (jnp.zeros((B, H, dk, dv), jnp.float32),
            jnp.zeros((B, H, dk), jnp.float32),
            jnp.zeros((B, H), jnp.float32))
    xs = (chunks4(q), chunks4(k), chunks4(v), chunks3(i_pre), chunks3(log_f))
    _, h = lax.scan(step, init, xs)
    return jnp.transpose(h, (1, 0, 3, 2, 4)).reshape(B, S, H, dv)


def _token_mixer(h, w_in, fox_f_bias, mlstm_conv_w, mlstm_conv_b, mlstm_i_bias,
                 mlstm_f_bias, mlstm_norm_g, w_out):
    B, S, _ = h.shape
    z = h @ w_in
    fq = z[..., COL_FOX_Q:COL_FOX_K].reshape(B, S, N_FOX_HEADS, FOX_HEAD_DIM)
    fk = z[..., COL_FOX_K:COL_FOX_V].reshape(B, S, N_FOX_HEADS, FOX_HEAD_DIM)
    fv = z[..., COL_FOX_V:COL_FOX_F].reshape(B, S, N_FOX_HEADS, FOX_HEAD_DIM)
    fox_logf = jax.nn.log_sigmoid((z[..., COL_FOX_F:COL_MLSTM_Q] + fox_f_bias).astype(jnp.float32))
    y_fox = _fox_attention(fq, fk, fv, fox_logf)
    qk = jax.nn.silu(_causal_dwconv(z[..., COL_MLSTM_Q:COL_MLSTM_V], mlstm_conv_w, mlstm_conv_b))
    mq = qk[..., :MLSTM_QK_WIDTH].reshape(B, S, N_MLSTM_HEADS, MLSTM_QK_DIM)
    mk = qk[..., MLSTM_QK_WIDTH:].reshape(B, S, N_MLSTM_HEADS, MLSTM_QK_DIM) * (MLSTM_QK_DIM ** -0.5)
    mv = z[..., COL_MLSTM_V:COL_MLSTM_I].reshape(B, S, N_MLSTM_HEADS, MLSTM_V_DIM)
    m_i = (z[..., COL_MLSTM_I:COL_MLSTM_F] + mlstm_i_bias).astype(jnp.float32)
    m_logf = jax.nn.log_sigmoid((z[..., COL_MLSTM_F:COL_MLSTM_O] + mlstm_f_bias).astype(jnp.float32))
    hm = _mlstm(mq, mk, mv, m_i, m_logf)
    hm = hm * lax.rsqrt(jnp.square(hm).mean(-1, keepdims=True) + LN_EPS)
    hm = hm * mlstm_norm_g.reshape(N_MLSTM_HEADS, MLSTM_V_DIM)
    o = jax.nn.sigmoid(z[..., COL_MLSTM_O:IN_WIDTH]).reshape(B, S, N_MLSTM_HEADS, MLSTM_V_DIM)
    y_mlstm = (o * hm).reshape(B, S, MLSTM_WIDTH).astype(h.dtype)
    y = jnp.concatenate([y_fox, y_mlstm], axis=-1)
    return y @ w_out


def _layer(x, c, w_ada, b_ada, ffn1_w_in, ffn1_w_out, ln1_g, ln1_b, w_in, fox_f_bias,
           mlstm_conv_w, mlstm_conv_b, mlstm_i_bias, mlstm_f_bias, mlstm_norm_g, w_out,
           ln2_g, ln2_b, ffn2_w_in, ffn2_w_out, ln3_g, ln3_b):
    ada = (jax.nn.silu(c) @ w_ada + b_ada)[:, None, :]
    sh1, sc1, g1, sh2, sc2, g2, sh3, sc3, g3 = jnp.split(ada, N_ADA, axis=-1)
    h = _swiglu(_modulate(x, sh1, sc1), ffn1_w_in, ffn1_w_out)
    x = _layernorm(ALPHA * x + 0.5 * (1 + g1) * h, ln1_g, ln1_b)
    h = _token_mixer(_modulate(x, sh2, sc2), w_in, fox_f_bias, mlstm_conv_w, mlstm_conv_b,
                     mlstm_i_bias, mlstm_f_bias, mlstm_norm_g, w_out)
    x = _layernorm(ALPHA * x + (1 + g2) * h, ln2_g, ln2_b)
    h = _swiglu(_modulate(x, sh3, sc3), ffn2_w_in, ffn2_w_out)
    x = _layernorm(ALPHA * x + 0.5 * (1 + g3) * h, ln3_g, ln3_b)
    return x


def setup_inputs(seed: int = 0) -> dict:
    key = jax.random.key(seed)
    ks = jax.random.split(key, 24)
    f32 = jnp.float32

    def nrm(k, shape, s):
        return jax.random.normal(k, shape, f32) * s

    D = D_MODEL
    return {
        'x': nrm(ks[0], (BATCH, SEQ, D), 1.0),
        'c': nrm(ks[1], (BATCH, D), 1.0),
        'w_ada': nrm(ks[2], (DEPTH, D, N_ADA * D), 0.1 * D ** -0.5),
        'b_ada': nrm(ks[3], (DEPTH, N_ADA * D), 0.01),
        'ffn1_w_in': nrm(ks[4], (DEPTH, D, 2 * D_FF), D ** -0.5),
        'ffn1_w_out': nrm(ks[5], (DEPTH, D_FF, D), BETA * D_FF ** -0.5),
        'ln1_g': 1.0 + nrm(ks[6], (DEPTH, D), 0.05),
        'ln1_b': nrm(ks[7], (DEPTH, D), 0.02),
        'w_in': nrm(ks[8], (DEPTH, D, IN_WIDTH), D ** -0.5),
        'fox_f_bias': jnp.linspace(1.0, 6.0, N_FOX_HEADS, dtype=f32)[None, :] + nrm(ks[9], (DEPTH, N_FOX_HEADS), 0.1),
        'mlstm_conv_w': nrm(ks[10], (DEPTH, CONV_WIDTH, 2 * MLSTM_QK_WIDTH), CONV_WIDTH ** -0.5),
        'mlstm_conv_b': nrm(ks[11], (DEPTH, 2 * MLSTM_QK_WIDTH), 0.02),
        'mlstm_i_bias': nrm(ks[12], (DEPTH, N_MLSTM_HEADS), 0.1),
        'mlstm_f_bias': jnp.linspace(3.0, 6.0, N_MLSTM_HEADS, dtype=f32)[None, :] + nrm(ks[13], (DEPTH, N_MLSTM_HEADS), 0.1),
        'mlstm_norm_g': 1.0 + nrm(ks[14], (DEPTH, MLSTM_WIDTH), 0.05),
        'w_out': nrm(ks[15], (DEPTH, MIX_WIDTH, D), BETA * MIX_WIDTH ** -0.5),
        'ln2_g': 1.0 + nrm(ks[16], (DEPTH, D), 0.05),
        'ln2_b': nrm(ks[17], (DEPTH, D), 0.02),
        'ffn2_w_in': nrm(ks[18], (DEPTH, D, 2 * D_FF), D ** -0.5),
        'ffn2_w_out': nrm(ks[19], (DEPTH, D_FF, D), BETA * D_FF ** -0.5),
        'ln3_g': 1.0 + nrm(ks[20], (DEPTH, D), 0.05),
        'ln3_b': nrm(ks[21], (DEPTH, D), 0.02),
    }


def reference(x, c, w_ada, b_ada, ffn1_w_in, ffn1_w_out, ln1_g, ln1_b, w_in, fox_f_bias,
              mlstm_conv_w, mlstm_conv_b, mlstm_i_bias, mlstm_f_bias, mlstm_norm_g, w_out,
              ln2_g, ln2_b, ffn2_w_in, ffn2_w_out, ln3_g, ln3_b):
    for l in range(DEPTH):
        x = _layer(x, c, w_ada[l], b_ada[l], ffn1_w_in[l], ffn1_w_out[l], ln1_g[l], ln1_b[l],
                   w_in[l], fox_f_bias[l], mlstm_conv_w[l], mlstm_conv_b[l], mlstm_i_bias[l],
                   mlstm_f_bias[l], mlstm_norm_g[l], w_out[l], ln2_g[l], ln2_b[l],
                   ffn2_w_in[l], ffn2_w_out[l], ln3_g[l], ln3_b[l])
    return x
```

```cpp
#define NONE 1
#include <hip/hip_runtime.h>
#include <hip/hip_cooperative_groups.h>
#include <hip/hip_bf16.h>
#include <cstdio>
#include <cstdint>
#include <cmath>
namespace cg = cooperative_groups;
namespace pg8 {
#define PG8_LAS __attribute__((address_space(3)))
typedef unsigned short bf16_t;
typedef short bf16x8 __attribute__((ext_vector_type(8)));
typedef float f32x4 __attribute__((ext_vector_type(4)));
typedef unsigned u32x4 __attribute__((ext_vector_type(4)));
constexpr int BM = 256, BK = 64, HALF = 128, HTB = HALF * BK * 2  , STAGE_BYTES = 8 * HTB, NXCD = 8, WGM = 8;

__host__ __device__ __forceinline__ int lds_byte(int r, int c) { const int st = (r >> 4) * 2 + (c >> 5), rr = r & 15, cc = c & 31, ob = rr * 64 + cc * 2; return st * 1024 + (ob ^ (((ob >> 9) & 1) << 5)); }
__host__ __device__ __forceinline__ void stage_rc(int b, int& R, int& C) { const int st = b / 1024, sb = b % 1024, swz = sb ^ (((sb >> 9) & 1) << 5); R = (st >> 1) * 16 + swz / 64; C = (st & 1) * 32 + (swz % 64) / 2; }
__host__ __device__ __forceinline__ int perm32(int rho) { const int n = rho >> 4, i = rho & 15; return 8 * (i >> 2) + 4 * n + (i & 3); }

struct Unit { int pm, pn; };
struct Gemm { const bf16_t* A; const bf16_t* Bt; int M, N, K; };

struct StaticOrder {
    int nM, nN, nwg, G, c;
    __host__ __device__ void init(int M, int N, int G_, int c_) { nM = M / BM; nN = N / BM; nwg = nM * nN; G = G_; c = c_; }
    __host__ __device__ bool next(int i, Unit& u) const {
        const long L = (long)i * G + c; if (L >= nwg) return false;
        int wgid = (int)L; { const int q = nwg / NXCD, r = nwg % NXCD, xcd = wgid % NXCD, off = wgid / NXCD; wgid = (xcd < r ? xcd * (q + 1) : r * (q + 1) + (xcd - r) * q) + off; }
        const int nig = WGM * nN, gid = wgid / nig, fm = gid * WGM, gsz = (nM - fm) < WGM ? (nM - fm) : WGM;
        u.pm = fm + ((wgid % nig) % gsz); u.pn = (wgid % nig) / gsz; return true;
    }
    __device__ __forceinline__ void a_ready(const Unit&) const {}
    __device__ __forceinline__ void done(const Unit&) const {}
};

typedef __bf16 bf16v2_t __attribute__((ext_vector_type(2)));
typedef float f32v2_t __attribute__((ext_vector_type(2)));
__device__ __forceinline__ unsigned cvt_pk_bf16(float lo, float hi) { const f32v2_t f = {lo, hi}; const bf16v2_t v = __builtin_convertvector(f, bf16v2_t); return __builtin_bit_cast(unsigned, v); }
typedef float f32x2 __attribute__((ext_vector_type(2)));
__device__ __forceinline__ f32x2 gelu_pk(f32x2 v) {
    const f32x2 av = __builtin_elementwise_abs(v), d = av * 0.2316418882f + 1.0f;
    f32x2 t; t.x = __builtin_amdgcn_rcpf(d.x); t.y = __builtin_amdgcn_rcpf(d.y);
    f32x2 q = t * 0.5307027145f + (-0.7265760135f); q = q * t + 0.7107068705f; q = q * t + (-0.142248368f); q = q * t + 0.127414796f; q = q * t;
    const f32x2 s = (v * v) * (-0.72134752044f);
    f32x2 e; e.x = __builtin_amdgcn_exp2f(s.x); e.y = __builtin_amdgcn_exp2f(s.y);
    const f32x2 m = v * (q * e), r = v - m;
    f32x2 o; o.x = v.x < 0.f ? m.x : r.x; o.y = v.y < 0.f ? m.y : r.y; return o;
}

template <int ACT  > struct EpiBf16 {
    static constexpr bool PERM = true, AFTER_DRAIN = false; static_assert(ACT == 0 || ACT == 1, "EpiBf16: ACT is 0 (none) or 1 (gelu_pk)");
    bf16_t* O; int ldc; const float* bias; int split_cols; size_t split_stride; float scale0;
    __device__ __forceinline__ void operator()(const f32x4 (&acc)[2][2][4][2], const Unit& u, int wr, int wc, int fr, int fq) const {
        const int row0 = u.pm * BM + wr * 64 + fr; int colt = u.pn * BM; bf16_t* base = O;
        float sc = 1.f; if (split_cols) { const int t = colt / split_cols; base += (size_t)t * split_stride; colt -= t * split_cols; if (t == 0) sc = scale0; }
        const int col0 = colt + wc * 32 + 8 * fq, bcol0 = u.pn * BM + wc * 32 + 8 * fq;
        f32x4 bv[2][2];
#pragma unroll
        for (int bj = 0; bj < 2; ++bj)
#pragma unroll
            for (int n = 0; n < 2; ++n) bv[bj][n] = bias ? *(const f32x4*)(bias + bcol0 + bj * HALF + 4 * n) : (f32x4){0.f, 0.f, 0.f, 0.f};
#pragma unroll
        for (int ai = 0; ai < 2; ++ai)
#pragma unroll
            for (int m = 0; m < 4; ++m) { bf16_t* rowp = base + (size_t)(row0 + ai * HALF + m * 16) * ldc + col0;
#pragma unroll
                for (int bj = 0; bj < 2; ++bj) { f32x4 v0 = acc[ai][bj][m][0] + bv[bj][0], v1 = acc[ai][bj][m][1] + bv[bj][1];
                    if (ACT == 1) { f32x2 a = gelu_pk((f32x2){v0[0], v0[1]}), b = gelu_pk((f32x2){v0[2], v0[3]}), c = gelu_pk((f32x2){v1[0], v1[1]}), d = gelu_pk((f32x2){v1[2], v1[3]});
                        v0 = (f32x4){a.x, a.y, b.x, b.y}; v1 = (f32x4){c.x, c.y, d.x, d.y}; }
                    v0 = v0 * sc; v1 = v1 * sc; u32x4 w; w.x = cvt_pk_bf16(v0[0], v0[1]); w.y = cvt_pk_bf16(v0[2], v0[3]); w.z = cvt_pk_bf16(v1[0], v1[1]); w.w = cvt_pk_bf16(v1[2], v1[3]);
                    *(u32x4*)(rowp + bj * HALF) = w; } }
    }
};

template <class Epi, class Sched, bool ALIGN_EPI = false, bool SP2 = false>
__device__ __forceinline__ void gemm_phase(PG8_LAS unsigned char* lds, const Gemm g, const Sched& S, const Epi& E) {
    int tid_l = threadIdx.x; asm volatile("" : "+v"(tid_l));
    const int tid = tid_l, wid = __builtin_amdgcn_readfirstlane(tid >> 6), lane = tid & 63, wr = wid >> 2, wc = wid & 3, fr = lane & 15, fq = lane >> 4;
    const int K = g.K, nt = K / BK;
    unsigned voffA[2], voffB[2];
#pragma unroll
    for (int i = 0; i < 2; ++i) { int R, C; stage_rc(tid * 16 + i * 8192, R, C); const int Rb = Epi::PERM ? ((R & ~31) + perm32(R & 31)) : R;
        voffA[i] = (unsigned)(R * K + C) * 2u; voffB[i] = (unsigned)(Rb * K + C) * 2u; }
    const size_t kstep = (size_t)(BK * 2);
    const size_t hstep = (size_t)HALF * K * 2;
    const size_t tstep = 2 * hstep;
    const unsigned ldsw = (unsigned)wid * 1024u;
    const int aoff = lds_byte(wr * 64 + fr, fq * 8), boff = lds_byte(wc * 32 + fr, fq * 8);
#define PG8_SA(b, h) (((b) * 2 + (h)) * HTB)
#define PG8_SB(b, h) ((4 + (b) * 2 + (h)) * HTB)
#define PG8_STAGE(bufoff, gbase, voff) do { _Pragma("unroll") for (int _i = 0; _i < 2; ++_i) \
        __builtin_amdgcn_global_load_lds((const unsigned*)((const char*)(gbase) + (voff)[_i]), (PG8_LAS unsigned*)(lds + (bufoff) + ldsw + _i * 8192), 16, 0, 0); } while (0)
#define PG8_LDA(dst, b, h) do { _Pragma("unroll") for (int m = 0; m < 4; ++m) _Pragma("unroll") for (int k = 0; k < 2; ++k) dst[m][k] = *(const PG8_LAS bf16x8*)(lds + PG8_SA(b, h) + aoff + m * 2048 + k * 1024); } while (0)
#define PG8_LDB(dst, b, h) do { _Pragma("unroll") for (int n = 0; n < 2; ++n) _Pragma("unroll") for (int k = 0; k < 2; ++k) dst[n][k] = *(const PG8_LAS bf16x8*)(lds + PG8_SB(b, h) + boff + n * 2048 + k * 1024); } while (0)
#define PG8_MMA(ai, bj, At, Bt) do { __builtin_amdgcn_s_setprio(1); _Pragma("unroll") for (int m = 0; m < 4; ++m) _Pragma("unroll") for (int n = 0; n < 2; ++n) _Pragma("unroll") for (int k = 0; k < 2; ++k) \
        acc[ai][bj][m][n] = __builtin_amdgcn_mfma_f32_16x16x32_bf16(Bt[n][k], At[m][k], acc[ai][bj][m][n], 0, 0, 0); __builtin_amdgcn_s_setprio(0); } while (0)
#define PG8_WAIT_V(n) asm volatile("s_waitcnt vmcnt(" #n ")" ::: "memory")
#define PG8_WAIT_L(n) asm volatile("s_waitcnt lgkmcnt(" #n ")" ::: "memory")
#define PG8_BAR __builtin_amdgcn_s_barrier()
#define PG8_SCHED __builtin_amdgcn_sched_barrier(0)
    Unit cur, nxt; int ui = 0;
    if (!S.next(0, cur)) return;
    f32x4 acc[2][2][4][2];
#pragma unroll
    for (int a = 0; a < 2; ++a)
#pragma unroll
        for (int b = 0; b < 2; ++b)
#pragma unroll
            for (int m = 0; m < 4; ++m)
#pragma unroll
                for (int n = 0; n < 2; ++n) acc[a][b][m][n] = (f32x4){0.f, 0.f, 0.f, 0.f};
    bf16x8 At[4][2], B0[2][2], B1[2][2];
    const char* cA = (const char*)g.A + (size_t)cur.pm * tstep; const char* cB = (const char*)g.Bt + (size_t)cur.pn * tstep;
    S.a_ready(cur);
    if constexpr (SP2) {
        PG8_STAGE(PG8_SB(0, 0), cB, voffB); PG8_STAGE(PG8_SB(0, 1), cB + hstep, voffB); PG8_STAGE(PG8_SA(0, 0), cA, voffA); PG8_STAGE(PG8_SA(0, 1), cA + hstep, voffA);
        if (wr == 1) PG8_BAR;
        PG8_WAIT_V(2); PG8_BAR;
        PG8_STAGE(PG8_SB(1, 0), cB + kstep, voffB); PG8_STAGE(PG8_SA(1, 0), cA + kstep, voffA); PG8_STAGE(PG8_SB(1, 1), cB + hstep + kstep, voffB);
        PG8_WAIT_V(6); PG8_BAR;
    } else {
        PG8_STAGE(PG8_SB(0, 0), cB, voffB); PG8_STAGE(PG8_SA(0, 0), cA, voffA); PG8_STAGE(PG8_SB(0, 1), cB + hstep, voffB); PG8_STAGE(PG8_SA(0, 1), cA + hstep, voffA);
        if (wr == 1) PG8_BAR;
        PG8_WAIT_V(4); PG8_BAR;
        PG8_STAGE(PG8_SB(1, 0), cB + kstep, voffB); PG8_STAGE(PG8_SA(1, 0), cA + kstep, voffA); PG8_STAGE(PG8_SB(1, 1), cB + hstep + kstep, voffB);
        PG8_WAIT_V(6); PG8_BAR;
    }
    for (;;) {
        const bool has_next = S.next(ui + 1, nxt);
        const char* nA = has_next ? (const char*)g.A + (size_t)nxt.pm * tstep : cA; const char* nB = has_next ? (const char*)g.Bt + (size_t)nxt.pn * tstep : cB;
        for (int t = 0; t < nt; t += 2) {
            const bool last = (t == nt - 2);
            const char* a1 = cA + (size_t)(t + 1) * kstep;
            const char* a2 = last ? nA : cA + (size_t)(t + 2) * kstep; const char* b2 = last ? nB : cB + (size_t)(t + 2) * kstep;
            const char* a3 = a2 + kstep; const char* b3 = b2 + kstep;
            if (last && has_next) S.a_ready(nxt);
            if constexpr (SP2) {
            PG8_LDB(B0, 0, 0); PG8_LDB(B1, 0, 1); PG8_SCHED; PG8_LDA(At, 0, 0); PG8_STAGE(PG8_SA(1, 1), a1 + hstep, voffA);
            PG8_WAIT_V(8); PG8_WAIT_L(0); PG8_BAR; PG8_MMA(0, 0, At, B0); PG8_MMA(0, 1, At, B1); PG8_BAR; PG8_SCHED;
            PG8_LDA(At, 0, 1); PG8_STAGE(PG8_SB(0, 0), b2, voffB); PG8_STAGE(PG8_SB(0, 1), b2 + hstep, voffB); PG8_STAGE(PG8_SA(0, 0), a2, voffA);
            PG8_WAIT_V(8); PG8_WAIT_L(0); PG8_BAR; PG8_MMA(1, 0, At, B0); PG8_MMA(1, 1, At, B1); PG8_BAR; PG8_SCHED;
            PG8_LDB(B0, 1, 0); PG8_LDB(B1, 1, 1); PG8_SCHED; PG8_LDA(At, 1, 0); PG8_STAGE(PG8_SA(0, 1), a2 + hstep, voffA);
            PG8_WAIT_V(8); PG8_WAIT_L(0); PG8_BAR; PG8_MMA(0, 0, At, B0); PG8_MMA(0, 1, At, B1); PG8_BAR; PG8_SCHED;
            PG8_LDA(At, 1, 1); PG8_STAGE(PG8_SB(1, 0), b3, voffB); PG8_STAGE(PG8_SB(1, 1), b3 + hstep, voffB); PG8_STAGE(PG8_SA(1, 0), a3, voffA);
            PG8_WAIT_V(8); PG8_WAIT_L(0); PG8_BAR; PG8_MMA(1, 0, At, B0); PG8_MMA(1, 1, At, B1); PG8_BAR; PG8_SCHED;
            } else {
            PG8_LDB(B0, 0, 0); PG8_SCHED; PG8_LDA(At, 0, 0); PG8_STAGE(PG8_SA(1, 1), a1 + hstep, voffA);
            PG8_WAIT_L(8); PG8_BAR; PG8_WAIT_L(0); PG8_MMA(0, 0, At, B0); PG8_BAR; PG8_SCHED;
            PG8_LDB(B1, 0, 1); PG8_STAGE(PG8_SB(0, 0), b2, voffB);
            PG8_BAR; PG8_WAIT_L(0); PG8_MMA(0, 1, At, B1); PG8_BAR;
            PG8_LDA(At, 0, 1); PG8_STAGE(PG8_SA(0, 0), a2, voffA);
            PG8_BAR; PG8_WAIT_L(0); PG8_MMA(1, 0, At, B0); PG8_BAR; PG8_SCHED;
            PG8_STAGE(PG8_SB(0, 1), b2 + hstep, voffB);
            PG8_WAIT_V(6); PG8_BAR; PG8_MMA(1, 1, At, B1); PG8_BAR;
            PG8_LDB(B0, 1, 0); PG8_SCHED; PG8_LDA(At, 1, 0); PG8_STAGE(PG8_SA(0, 1), a2 + hstep, voffA);
            PG8_WAIT_L(8); PG8_BAR; PG8_WAIT_L(0); PG8_MMA(0, 0, At, B0); PG8_BAR; PG8_SCHED;
            PG8_LDB(B1, 1, 1); PG8_STAGE(PG8_SB(1, 0), b3, voffB);
            PG8_BAR; PG8_WAIT_L(0); PG8_MMA(0, 1, At, B1); PG8_BAR;
            PG8_LDA(At, 1, 1); PG8_STAGE(PG8_SA(1, 0), a3, voffA);
            PG8_BAR; PG8_WAIT_L(0); PG8_MMA(1, 0, At, B0); PG8_BAR; PG8_SCHED;
            PG8_STAGE(PG8_SB(1, 1), b3 + hstep, voffB);
            PG8_WAIT_V(6); PG8_BAR; PG8_MMA(1, 1, At, B1); PG8_BAR;
            }
        }
        if constexpr (ALIGN_EPI) { if (wr == 0) PG8_BAR; }
        if constexpr (!Epi::AFTER_DRAIN) { E(acc, cur, wr, wc, fr, fq); S.done(cur); }
        if (!has_next) break;
#pragma unroll
        for (int a = 0; a < 2; ++a)
#pragma unroll
            for (int b = 0; b < 2; ++b)
#pragma unroll
                for (int m = 0; m < 4; ++m)
#pragma unroll
                    for (int n = 0; n < 2; ++n) acc[a][b][m][n] = (f32x4){0.f, 0.f, 0.f, 0.f};
        cur = nxt; cA = nA; cB = nB; ++ui;
        if constexpr (ALIGN_EPI) { if (wr == 1) PG8_BAR; }
    }
    PG8_WAIT_V(0);
    if constexpr (!ALIGN_EPI) { if (wr == 0) PG8_BAR; }
    PG8_BAR;
    if constexpr (Epi::AFTER_DRAIN) { E.fused(acc, cur, wr, wc, fr, fq, lds, wid, lane); S.done(cur); }
#undef PG8_SA
#undef PG8_SB
#undef PG8_STAGE
#undef PG8_LDA
#undef PG8_LDB
#undef PG8_MMA
#undef PG8_WAIT_V
#undef PG8_WAIT_L
#undef PG8_BAR
#undef PG8_SCHED
}
}
namespace pg8 {
typedef unsigned u32x2 __attribute__((ext_vector_type(2)));
__device__ __forceinline__ float sigmoid_f(float v) { return __builtin_amdgcn_rcpf(1.0f + __builtin_amdgcn_exp2f(-1.4426950408889634f * v)); }
__device__ __forceinline__ float silu_f(float v) { return v * sigmoid_f(v); }
__device__ __forceinline__ float logsigmoid_f(float v) { return fminf(v, 0.f) - log1pf(__expf(-fabsf(v))); }
struct EpiSwiglu {
    static constexpr bool PERM = true, AFTER_DRAIN = false;
    bf16_t* H; int ldh;
    __device__ __forceinline__ void operator()(const f32x4 (&acc)[2][2][4][2], const Unit& u, int wr, int wc, int fr, int fq) const {
        const int row0 = u.pm * BM + wr * 64 + fr, col0 = u.pn * HALF + wc * 32 + 8 * fq;
#pragma unroll
        for (int ai = 0; ai < 2; ++ai)
#pragma unroll
            for (int m = 0; m < 4; ++m) { bf16_t* rowp = H + (size_t)(row0 + ai * HALF + m * 16) * ldh + col0;
                const f32x4 g0 = acc[ai][0][m][0], g1 = acc[ai][0][m][1], u0 = acc[ai][1][m][0], u1 = acc[ai][1][m][1];
                u32x4 w; w.x = cvt_pk_bf16(silu_f(g0[0]) * u0[0], silu_f(g0[1]) * u0[1]); w.y = cvt_pk_bf16(silu_f(g0[2]) * u0[2], silu_f(g0[3]) * u0[3]);
                w.z = cvt_pk_bf16(silu_f(g1[0]) * u1[0], silu_f(g1[1]) * u1[1]); w.w = cvt_pk_bf16(silu_f(g1[2]) * u1[2], silu_f(g1[3]) * u1[3]);
                *(u32x4*)rowp = w; }
    }
};
struct EpiResid {
    static constexpr bool PERM = false, AFTER_DRAIN = false;
    const float* xin; float* out; const float* gate; float alpha, gs; int rows_per_batch, gate_stride;
    __device__ __forceinline__ void operator()(const f32x4 (&acc)[2][2][4][2], const Unit& u, int wr, int wc, int fr, int fq) const {
        const int b = (u.pm * BM) / rows_per_batch; const float* gp = gate + (size_t)b * gate_stride;
        const int col0 = u.pn * BM + wc * 32 + 4 * fq, row0 = u.pm * BM + wr * 64 + fr;
#pragma unroll
        for (int bj = 0; bj < 2; ++bj)
#pragma unroll
            for (int n = 0; n < 2; ++n) { const int c = col0 + bj * HALF + n * 16; const f32x4 gv = (*(const f32x4*)(gp + c) + 1.0f) * gs;
#pragma unroll
                for (int ai = 0; ai < 2; ++ai)
#pragma unroll
                    for (int m = 0; m < 4; ++m) { const size_t off = (size_t)(row0 + ai * HALF + m * 16) * 2048 + c;
                        const f32x4 xv = *(const f32x4*)(xin + off); *(f32x4*)(out + off) = xv * alpha + gv * acc[ai][bj][m][n]; } }
    }
};
struct EpiInproj {
    static constexpr bool PERM = true, AFTER_DRAIN = false;
    bf16_t* Z; float* gates; const float* fox_fb; const float* ml_ib; const float* ml_fb;
    __device__ __forceinline__ void operator()(const f32x4 (&acc)[2][2][4][2], const Unit& u, int wr, int wc, int fr, int fq) const {
        const int row0 = u.pm * BM + wr * 64 + fr;
        if (u.pn < 24) {
            const int col0 = u.pn * BM + wc * 32 + 8 * fq; const bool sg = u.pn >= 20;
#pragma unroll
            for (int ai = 0; ai < 2; ++ai)
#pragma unroll
                for (int m = 0; m < 4; ++m) { bf16_t* rowp = Z + (size_t)(row0 + ai * HALF + m * 16) * 6144 + col0;
#pragma unroll
                    for (int bj = 0; bj < 2; ++bj) { f32x4 v0 = acc[ai][bj][m][0], v1 = acc[ai][bj][m][1];
                        if (sg) { v0 = (f32x4){sigmoid_f(v0[0]), sigmoid_f(v0[1]), sigmoid_f(v0[2]), sigmoid_f(v0[3])}; v1 = (f32x4){sigmoid_f(v1[0]), sigmoid_f(v1[1]), sigmoid_f(v1[2]), sigmoid_f(v1[3])}; }
                        u32x4 w; w.x = cvt_pk_bf16(v0[0], v0[1]); w.y = cvt_pk_bf16(v0[2], v0[3]); w.z = cvt_pk_bf16(v1[0], v1[1]); w.w = cvt_pk_bf16(v1[2], v1[3]);
                        *(u32x4*)(rowp + bj * HALF) = w; } }
        } else if (wc == 0 && fq < 2) {
#pragma unroll
            for (int ai = 0; ai < 2; ++ai)
#pragma unroll
                for (int m = 0; m < 4; ++m) { float* gp = gates + (size_t)(row0 + ai * HALF + m * 16) * 16 + 8 * fq;
#pragma unroll
                    for (int n = 0; n < 2; ++n) { const f32x4 v = acc[ai][0][m][n]; f32x4 o;
                        if (fq == 0) { const f32x4 bb = *(const f32x4*)(fox_fb + 4 * n); o = (f32x4){logsigmoid_f(v[0] + bb[0]), logsigmoid_f(v[1] + bb[1]), logsigmoid_f(v[2] + bb[2]), logsigmoid_f(v[3] + bb[3])}; }
                        else if (n == 0) { const f32x4 bb = *(const f32x4*)ml_ib; o = v + bb; }
                        else { const f32x4 bb = *(const f32x4*)ml_fb; o = (f32x4){logsigmoid_f(v[0] + bb[0]), logsigmoid_f(v[1] + bb[1]), logsigmoid_f(v[2] + bb[2]), logsigmoid_f(v[3] + bb[3])}; }
                        *(f32x4*)(gp + 4 * n) = o; } }
        }
    }
};
}
namespace mk {
using pg8::bf16_t; using pg8::bf16x8; using pg8::f32x4; using pg8::u32x4; using pg8::u32x2;
#define LAS __attribute__((address_space(3)))
constexpr int NT = 512, NWV = 8;
constexpr int T = 32768, SEQ = 16384, DM = 2048, DFF = 5632, NINP = 6400, ZP = 6144, NADA = 18432, INW = 6160;
constexpr float ALPHA = 1.189207115002721f, LN_EPS = 1e-5f, SQRT_DH = 11.313708498984761f, RSQRT_DK = 0.08838834764831845f;
constexpr size_t MiB = 1u << 20;
constexpr size_t WS_ADA = 0, WS_GATES = 1 * MiB, WS_FS = 3 * MiB, WS_BCS = 4 * MiB, WS_SCAL = 4 * MiB + 768 * 1024, WS_NST = 5 * MiB;
constexpr size_t WS_W1T = 8 * MiB, WS_W1O = 52 * MiB, WS_WIN = 74 * MiB, WS_WOT = 99 * MiB, WS_W2T = 107 * MiB, WS_W2O = 151 * MiB;
constexpr size_t WS_A = 176 * MiB, WS_Z = 304 * MiB, WS_QKC = 688 * MiB, WS_CST = 752 * MiB, WS_END = 880 * MiB;
constexpr int LDS_BYTES = 147456;

struct Params {
    const float *x, *c, *w_ada, *b_ada, *f1_in, *f1_out, *ln1_g, *ln1_b, *w_in, *fox_fb, *conv_w, *conv_b, *ml_ib, *ml_fb, *ml_ng, *w_out, *ln2_g, *ln2_b, *f2_in, *f2_out, *ln3_g, *ln3_b;
    float* out; unsigned char* ws;
};
__device__ __forceinline__ unsigned pk2(float a, float b) { return pg8::cvt_pk_bf16(a, b); }
__device__ __forceinline__ float bf2f(unsigned short h) { return __uint_as_float((unsigned)h << 16); }
__device__ __forceinline__ float wave_sum(float v) {
#pragma unroll
    for (int o = 1; o < 64; o <<= 1) v += __shfl_xor(v, o);
    return v;
}
#define LDS_WAIT() asm volatile("s_waitcnt lgkmcnt(0)" ::: "memory")

__device__ __forceinline__ void transpose_item(const float* W, int N, int K, bf16_t* WT, int src_col, int dst_row, int k0, LAS float* scr, int lane) {
#pragma unroll 8
    for (int i = 0; i < 32; ++i) { const int kk = 2 * i + (lane >> 5); scr[kk * 33 + (lane & 31)] = W[(size_t)(k0 + kk) * N + src_col + (lane & 31)]; }
    LDS_WAIT();
    const int c = lane & 7;
#pragma unroll
    for (int j = 0; j < 4; ++j) { const int n = (lane >> 3) + 8 * j; const LAS float* s = scr + (8 * c) * 33 + n;
        u32x4 o; o.x = pk2(s[0 * 33], s[1 * 33]); o.y = pk2(s[2 * 33], s[3 * 33]); o.z = pk2(s[4 * 33], s[5 * 33]); o.w = pk2(s[6 * 33], s[7 * 33]);
        *(u32x4*)(WT + (size_t)(dst_row + n) * K + k0 + 8 * c) = o; }
    LDS_WAIT();
}
__device__ __forceinline__ void p0_prologue(const Params& p, LAS unsigned char* lds) {
    int tid_l = threadIdx.x; asm volatile("" : "+v"(tid_l)); const int tid = tid_l, lane = tid & 63, wave = tid >> 6;
    unsigned char* ws = p.ws;
    float* ada = (float*)(ws + WS_ADA);
    if (blockIdx.x < NADA / 128) {
        LAS float* sc = (LAS float*)lds;
        LAS float* red = (LAS float*)(lds + 16384);
        for (int i = tid; i < 2 * DM; i += NT) { const float v = p.c[i]; sc[i] = pg8::silu_f(v); }
        __syncthreads();
        const int cl = tid & 31, kg = tid >> 5, col = blockIdx.x * 128 + 4 * cl;
        f32x4 a0 = {0.f, 0.f, 0.f, 0.f}, a1 = {0.f, 0.f, 0.f, 0.f};
#pragma unroll 8
        for (int kk = 0; kk < 128; ++kk) { const int k = kg * 128 + kk; const f32x4 w = *(const f32x4*)(p.w_ada + (size_t)k * NADA + col);
            a0 += w * sc[k]; a1 += w * sc[DM + k]; }
        *(LAS f32x4*)(red + (kg * 2 + 0) * 128 + 4 * cl) = a0; *(LAS f32x4*)(red + (kg * 2 + 1) * 128 + 4 * cl) = a1;
        __syncthreads();
        if (tid < 256) { const int b = tid >> 7, cc = tid & 127; float s = p.b_ada[blockIdx.x * 128 + cc];
#pragma unroll
            for (int g = 0; g < 16; ++g) s += red[(g * 2 + b) * 128 + cc];
            ada[b * NADA + blockIdx.x * 128 + cc] = s; }
        __syncthreads();
    }
    LAS float* scr = (LAS float*)(lds + wave * 16384);
    const int gw = blockIdx.x * NWV + wave, NGW = gridDim.x * NWV;
    constexpr int I_F1I = 32 * 352, I_F1O = 88 * 64, I_WIN = 32 * 192, I_WOT = 32 * 64;
    constexpr int NITEMS = 2 * (I_F1I + I_F1O) + I_WIN + I_WOT;
    bf16_t* W1T = (bf16_t*)(ws + WS_W1T); bf16_t* W1O = (bf16_t*)(ws + WS_W1O); bf16_t* WIN = (bf16_t*)(ws + WS_WIN); bf16_t* WOT = (bf16_t*)(ws + WS_WOT);
    bf16_t* W2T = (bf16_t*)(ws + WS_W2T); bf16_t* W2O = (bf16_t*)(ws + WS_W2O);
    for (int it = gw; it < NITEMS; it += NGW) {
        int r = it;
        if (r < 2 * I_F1I) {
            const bool second = r >= I_F1I; if (second) r -= I_F1I;
            const int kb = r / 352, db = r % 352, pn = db >> 3, wi = db & 7;
            const int src = (wi < 4) ? (128 * pn + 32 * wi) : (DFF + 128 * pn + 32 * (wi - 4));
            transpose_item(second ? p.f2_in : p.f1_in, 2 * DFF, DM, second ? W2T : W1T, src, 32 * db, 64 * kb, scr, lane); continue; }
        r -= 2 * I_F1I;
        if (r < 2 * I_F1O) { const bool second = r >= I_F1O; if (second) r -= I_F1O;
            const int kb = r / 64, db = r % 64;
            transpose_item(second ? p.f2_out : p.f1_out, DM, DFF, second ? W2O : W1O, 32 * db, 32 * db, 64 * kb, scr, lane); continue; }
        r -= 2 * I_F1O;
        if (r < I_WIN) { const int kb = r / 192, db = r % 192, dst = 32 * db;
            const int src = dst < 3072 ? dst : (dst < 4096 ? 3080 + (dst - 3072) : (dst < 5120 ? 4104 + (dst - 4096) : 5136 + (dst - 5120)));
            transpose_item(p.w_in, INW, DM, WIN, src, dst, 64 * kb, scr, lane); continue; }
        r -= I_WIN;
        { const int kb = r / 64, db = r % 64; transpose_item(p.w_out, DM, DM, WOT, 32 * db, 32 * db, 64 * kb, scr, lane); }
    }
    for (int idx = blockIdx.x * NT + tid; idx < 256 * DM; idx += gridDim.x * NT) { const int r = idx >> 11, k = idx & (DM - 1);
        const int src = r < 8 ? 3072 + r : (r < 12 ? 5128 + (r - 8) : (r < 16 ? 5132 + (r - 12) : -1));
        const float v = src >= 0 ? p.w_in[(size_t)k * INW + src] : 0.f;
        WIN[(size_t)(6144 + r) * DM + k] = (bf16_t)(pk2(v, 0.f) & 0xffffu); }
}

template <int MODE>
__device__ __forceinline__ void ln_phase(const float* in, float* xout, bf16_t* aout, const float* g, const float* bb, const float* ada_shift, const float* ada_scale) {
    int tid_l = threadIdx.x; asm volatile("" : "+v"(tid_l)); const int tid = tid_l, lane = tid & 63, wave = tid >> 6;
    const int gw = blockIdx.x * NWV + wave, NGW = gridDim.x * NWV;
    f32x4 gv[8], bv[8];
    if (MODE != 0) {
#pragma unroll
        for (int j = 0; j < 8; ++j) { gv[j] = *(const f32x4*)(g + 256 * j + 4 * lane); bv[j] = *(const f32x4*)(bb + 256 * j + 4 * lane); }
    }
    for (int row = gw; row < T; row += NGW) {
        const int b = row >> 14;
        const f32x4* xr = (const f32x4*)(in + (size_t)row * DM) + lane;
        f32x4 v[8]; float s = 0.f;
#pragma unroll
        for (int j = 0; j < 8; ++j) { v[j] = xr[64 * j]; s += (v[j][0] + v[j][1]) + (v[j][2] + v[j][3]); }
        float mean = wave_sum(s) * (1.f / DM); float s2 = 0.f;
#pragma unroll
        for (int j = 0; j < 8; ++j) { v[j] = v[j] - mean; s2 += (v[j][0] * v[j][0] + v[j][1] * v[j][1]) + (v[j][2] * v[j][2] + v[j][3] * v[j][3]); }
        float rstd = 1.0f / sqrtf(wave_sum(s2) * (1.f / DM) + LN_EPS);
        if (MODE != 0) {
            f32x4* xo = (f32x4*)(xout + (size_t)row * DM) + lane; s = 0.f;
#pragma unroll
            for (int j = 0; j < 8; ++j) { v[j] = v[j] * rstd * gv[j] + bv[j]; xo[64 * j] = v[j]; s += (v[j][0] + v[j][1]) + (v[j][2] + v[j][3]); }
            if (MODE == 1) {
                mean = wave_sum(s) * (1.f / DM); s2 = 0.f;
#pragma unroll
                for (int j = 0; j < 8; ++j) { v[j] = v[j] - mean; s2 += (v[j][0] * v[j][0] + v[j][1] * v[j][1]) + (v[j][2] * v[j][2] + v[j][3] * v[j][3]); }
                rstd = 1.0f / sqrtf(wave_sum(s2) * (1.f / DM) + LN_EPS);
            }
        }
        if (MODE != 2) {
            const float* sh = ada_shift + (size_t)b * NADA; const float* sc = ada_scale + (size_t)b * NADA;
            u32x2* ao = (u32x2*)(aout + (size_t)row * DM) + lane;
#pragma unroll
            for (int j = 0; j < 8; ++j) { const f32x4 shv = *(const f32x4*)(sh + 256 * j + 4 * lane), scv = *(const f32x4*)(sc + 256 * j + 4 * lane);
                const f32x4 y = v[j] * rstd * (scv + 1.0f) + shv; u32x2 w; w.x = pk2(y[0], y[1]); w.y = pk2(y[2], y[3]); ao[64 * j] = w; }
        }
    }
}
__device__ __forceinline__ void p6_scalars_conv(const Params& p, LAS unsigned char* lds) {
    int tid_l = threadIdx.x; asm volatile("" : "+v"(tid_l)); const int tid = tid_l, lane = tid & 63, wave = tid >> 6;
    unsigned char* ws = p.ws;
    const float* gates = (const float*)(ws + WS_GATES);
    float* Fs = (float*)(ws + WS_FS); float* bcs = (float*)(ws + WS_BCS); float* scal = (float*)(ws + WS_SCAL);
    for (int task = blockIdx.x; task < 24; task += gridDim.x) {
        if (task < 16) {
            const int b = task >> 3, h = task & 7; LAS float* wt = (LAS float*)lds;
            const float* gp = gates + ((size_t)b * SEQ + (size_t)tid * 32) * 16 + h;
            float v[32]; float run = 0.f;
#pragma unroll
            for (int i = 0; i < 32; ++i) { run += gp[i * 16]; v[i] = run; }
            float inc = run;
#pragma unroll
            for (int o = 1; o < 64; o <<= 1) { const float t = __shfl_up(inc, o); if (lane >= o) inc += t; }
            if (lane == 63) wt[wave] = inc;
            __syncthreads();
            float off = inc - run;
            for (int w = 0; w < wave; ++w) off += wt[w];
            float* fo = Fs + (size_t)task * SEQ + tid * 32;
#pragma unroll
            for (int i = 0; i < 32; ++i) fo[i] = (v[i] + off) * SQRT_DH;
            __syncthreads();
        } else {
            const int bh = task - 16, b = bh >> 2, h = bh & 3; LAS float* bLs = (LAS float*)lds; LAS float* mls = bLs + 256;
            if (tid < 256) { const float* gp = gates + ((size_t)b * SEQ + (size_t)tid * 64) * 16; float run = 0.f, mx = -INFINITY;
                float* bo = bcs + (size_t)bh * SEQ + tid * 64;
                for (int s = 0; s < 64; ++s) { run += gp[s * 16 + 12 + h]; bo[s] = run; mx = fmaxf(mx, gp[s * 16 + 8 + h] - run); }
                bLs[tid] = run; mls[tid] = run + mx; }
            __syncthreads();
            if (tid == 0) { float m = 0.f;
                for (int k = 0; k < 256; ++k) { const float bl = bLs[k], mn = fmaxf(bl + m, mls[k]); float* so = scal + (size_t)(bh * 256 + k) * 4;
                    so[0] = m; so[1] = mn; so[2] = __expf(bl + m - mn); so[3] = 0.f; m = mn; } }
            __syncthreads();
        }
    }
    const bf16_t* Z = (const bf16_t*)(ws + WS_Z); bf16_t* QKc = (bf16_t*)(ws + WS_QKC);
    const int gt = blockIdx.x * NT + tid, cgp = gt & 127, c0 = 8 * cgp;
    float cw[4][8], cb[8];
#pragma unroll
    for (int i = 0; i < 8; ++i) { cb[i] = p.conv_b[c0 + i];
#pragma unroll
        for (int j = 0; j < 4; ++j) cw[j][i] = p.conv_w[j * 1024 + c0 + i]; }
    const float osc = c0 >= 512 ? RSQRT_DK : 1.0f;
    for (int r = gt >> 7; r < T; r += (gridDim.x * NT) >> 7) {
        const int t = r & (SEQ - 1);
        float a[8];
#pragma unroll
        for (int i = 0; i < 8; ++i) a[i] = cb[i];
#pragma unroll
        for (int j = 0; j < 4; ++j) { if (t - 3 + j >= 0) { const u32x4 z = *(const u32x4*)(Z + (size_t)(r - 3 + j) * ZP + 3072 + c0);
#pragma unroll
                for (int q = 0; q < 4; ++q) { a[2 * q] += cw[j][2 * q] * __uint_as_float(z[q] << 16); a[2 * q + 1] += cw[j][2 * q + 1] * __uint_as_float(z[q] & 0xffff0000u); } } }
        u32x4 o;
#pragma unroll
        for (int q = 0; q < 4; ++q) o[q] = pk2(pg8::silu_f(a[2 * q]) * osc, pg8::silu_f(a[2 * q + 1]) * osc);
        *(u32x4*)(QKc + (size_t)r * 1024 + c0) = o;
    }
}

__device__ __forceinline__ void p7_mlstm_local(const Params& p, LAS unsigned char* lds) {
    int tid_l = threadIdx.x; asm volatile("" : "+v"(tid_l)); const int tid = tid_l, lane = tid & 63, wave = __builtin_amdgcn_readfirstlane(tid >> 6), fr = lane & 15, fq = lane >> 4;
    unsigned char* ws = p.ws;
    const float* gates = (const float*)(ws + WS_GATES); const float* bcs = (const float*)(ws + WS_BCS); const float* scal = (const float*)(ws + WS_SCAL);
    const bf16_t* Z = (const bf16_t*)(ws + WS_Z); const bf16_t* QKc = (const bf16_t*)(ws + WS_QKC);
    bf16_t* Cst = (bf16_t*)(ws + WS_CST); float* nst = (float*)(ws + WS_NST);
    LAS bf16_t* wKt = (LAS bf16_t*)lds;
    LAS bf16_t* Vt = (LAS bf16_t*)(lds + 18432);
    LAS float* wts = (LAS float*)(lds + 55296);
    LAS float* nred = (LAS float*)(lds + 55808);
    for (int u = blockIdx.x; u < 2048; u += gridDim.x) {
        const int bh = u >> 8, k = u & 255, b = bh >> 2, h = bh & 3; const size_t row0 = (size_t)b * SEQ + 64 * k;
        if (tid < 64) { const float* bp = bcs + (size_t)bh * SEQ + 64 * k; const float bL = bp[63], bs = bp[tid], ig = gates[(row0 + tid) * 16 + 8 + h], mk = scal[(size_t)u * 4 + 1];
            wts[tid] = __expf(bL - bs + ig - mk); }
        __syncthreads();
#pragma unroll
        for (int i = 0; i < 2; ++i) { const int pc = tid + NT * i, s = pc >> 4, d0 = (pc & 15) * 8; const float w = wts[s];
            const u32x4 kv = *(const u32x4*)(QKc + (row0 + s) * 1024 + 512 + 128 * h + d0);
#pragma unroll
            for (int q = 0; q < 4; ++q) { const unsigned pr = pk2(__uint_as_float(kv[q] << 16) * w, __uint_as_float(kv[q] & 0xffff0000u) * w);
                wKt[(d0 + 2 * q) * 72 + s] = (bf16_t)(pr & 0xffffu); wKt[(d0 + 2 * q + 1) * 72 + s] = (bf16_t)(pr >> 16); } }
#pragma unroll
        for (int i = 0; i < 4; ++i) { const int pc = tid + NT * i, s = pc >> 5, v0 = (pc & 31) * 8;
            const u32x4 vv = *(const u32x4*)(Z + (row0 + s) * ZP + 4096 + 256 * h + v0);
#pragma unroll
            for (int q = 0; q < 4; ++q) { Vt[(v0 + 2 * q) * 72 + s] = (bf16_t)(vv[q] & 0xffffu); Vt[(v0 + 2 * q + 1) * 72 + s] = (bf16_t)(vv[q] >> 16); } }
        __syncthreads();
        f32x4 acc[8][2];
#pragma unroll
        for (int dt = 0; dt < 8; ++dt) { acc[dt][0] = (f32x4){0.f, 0.f, 0.f, 0.f}; acc[dt][1] = (f32x4){0.f, 0.f, 0.f, 0.f}; }
#pragma unroll
        for (int ks = 0; ks < 2; ++ks) {
            bf16x8 bfr[2];
#pragma unroll
            for (int vt = 0; vt < 2; ++vt) bfr[vt] = *(const LAS bf16x8*)(Vt + (32 * wave + 16 * vt + fr) * 72 + 32 * ks + 8 * fq);
#pragma unroll
            for (int dt = 0; dt < 8; ++dt) { const bf16x8 a = *(const LAS bf16x8*)(wKt + (16 * dt + fr) * 72 + 32 * ks + 8 * fq);
                acc[dt][0] = __builtin_amdgcn_mfma_f32_16x16x32_bf16(a, bfr[0], acc[dt][0], 0, 0, 0);
                acc[dt][1] = __builtin_amdgcn_mfma_f32_16x16x32_bf16(a, bfr[1], acc[dt][1], 0, 0, 0); }
        }
        bf16_t* co = Cst + (size_t)u * 32768;
#pragma unroll
        for (int dt = 0; dt < 8; ++dt)
#pragma unroll
            for (int vt = 0; vt < 2; ++vt) { u32x2 w; w.x = pk2(acc[dt][vt][0], acc[dt][vt][1]); w.y = pk2(acc[dt][vt][2], acc[dt][vt][3]);
                *(u32x2*)(co + (size_t)(32 * wave + 16 * vt + fr) * 128 + 16 * dt + 4 * fq) = w; }
        { const int d = tid & 127, part = tid >> 7; float s = 0.f;
#pragma unroll
            for (int i = 0; i < 16; ++i) s += bf2f(wKt[d * 72 + 16 * part + i]);
            nred[part * 128 + d] = s; }
        __syncthreads();
        if (tid < 128) nst[(size_t)u * 128 + tid] = (nred[tid] + nred[128 + tid]) + (nred[256 + tid] + nred[384 + tid]);
        __syncthreads();
    }
}

__device__ __forceinline__ void p8_mlstm_scan(const Params& p) {
    unsigned char* ws = p.ws; const float* scal = (const float*)(ws + WS_SCAL);
    unsigned* Cst = (unsigned*)(ws + WS_CST); float* nst = (float*)(ws + WS_NST);
    const int gt = blockIdx.x * NT + threadIdx.x, NTH = gridDim.x * NT;
    for (int it = gt; it < 8 * 16384; it += NTH) {
        const int bh = it >> 14, e = it & 16383; unsigned* cp = Cst + (size_t)bh * 256 * 16384 + e; const float* sp = scal + (size_t)bh * 256 * 4 + 2;
        float s0 = 0.f, s1 = 0.f;
        for (int k0 = 0; k0 < 256; k0 += 8) { unsigned loc[8]; float dk[8];
#pragma unroll
            for (int j = 0; j < 8; ++j) { loc[j] = cp[(size_t)(k0 + j) * 16384]; dk[j] = sp[(k0 + j) * 4]; }
#pragma unroll
            for (int j = 0; j < 8; ++j) { cp[(size_t)(k0 + j) * 16384] = pk2(s0, s1);
                s0 = dk[j] * s0 + __uint_as_float(loc[j] << 16); s1 = dk[j] * s1 + __uint_as_float(loc[j] & 0xffff0000u); } }
    }
    for (int it = gt; it < 8 * 128; it += NTH) { const int bh = it >> 7, d = it & 127; float* np = nst + (size_t)bh * 256 * 128 + d; const float* sp = scal + (size_t)bh * 256 * 4 + 2;
        float s = 0.f;
        for (int k = 0; k < 256; ++k) { const float loc = np[k * 128]; np[k * 128] = s; s = sp[k * 4] * s + loc; } }
}
__device__ __forceinline__ void p9_mlstm_out(const Params& p, LAS unsigned char* lds) {
    int tid_l = threadIdx.x; asm volatile("" : "+v"(tid_l)); const int tid = tid_l, lane = tid & 63, wave = __builtin_amdgcn_readfirstlane(tid >> 6), fr = lane & 15, fq = lane >> 4;
    unsigned char* ws = p.ws;
    const float* gates = (const float*)(ws + WS_GATES); const float* bcs = (const float*)(ws + WS_BCS); const float* scal = (const float*)(ws + WS_SCAL);
    const bf16_t* Z = (const bf16_t*)(ws + WS_Z); const bf16_t* QKc = (const bf16_t*)(ws + WS_QKC);
    const bf16_t* Cst = (const bf16_t*)(ws + WS_CST); const float* nst = (const float*)(ws + WS_NST); bf16_t* Y = (bf16_t*)(ws + WS_A);
    LAS bf16_t* Qs = (LAS bf16_t*)lds;
    LAS bf16_t* Ks = (LAS bf16_t*)(lds + 17408);
    LAS bf16_t* Vt = (LAS bf16_t*)(lds + 34816);
    LAS bf16_t* St = (LAS bf16_t*)(lds + 71680);
    LAS float* fb = (LAS float*)(lds + 80896);
    LAS float* bt = fb; LAS float* ig = fb + 64; LAS float* mt = fb + 128; LAS float* inter = fb + 192; LAS float* scl = fb + 256; LAS float* ssq = fb + 320; LAS float* nprev = fb + 384; LAS float* ssqw = fb + 512;
    for (int u = blockIdx.x; u < 2048; u += gridDim.x) {
        const int bh = u >> 8, k = u & 255, b = bh >> 2, h = bh & 3; const size_t row0 = (size_t)b * SEQ + 64 * k;
        const float mprev = scal[(size_t)u * 4 + 0];
        bf16x8 cfr[2][4];
#pragma unroll
        for (int vt = 0; vt < 2; ++vt)
#pragma unroll
            for (int ks = 0; ks < 4; ++ks) cfr[vt][ks] = *(const bf16x8*)(Cst + (size_t)u * 32768 + (size_t)(32 * wave + 16 * vt + fr) * 128 + 32 * ks + 8 * fq);
#pragma unroll
        for (int i = 0; i < 2; ++i) { const int pc = tid + NT * i, s = pc >> 4, d0 = (pc & 15) * 8;
            *(LAS u32x4*)(Qs + s * 136 + d0) = *(const u32x4*)(QKc + (row0 + s) * 1024 + 128 * h + d0);
            *(LAS u32x4*)(Ks + s * 136 + d0) = *(const u32x4*)(QKc + (row0 + s) * 1024 + 512 + 128 * h + d0); }
#pragma unroll
        for (int i = 0; i < 4; ++i) { const int pc = tid + NT * i, s = pc >> 5, v0 = (pc & 31) * 8;
            const u32x4 vv = *(const u32x4*)(Z + (row0 + s) * ZP + 4096 + 256 * h + v0);
#pragma unroll
            for (int q = 0; q < 4; ++q) { Vt[(v0 + 2 * q) * 72 + s] = (bf16_t)(vv[q] & 0xffffu); Vt[(v0 + 2 * q + 1) * 72 + s] = (bf16_t)(vv[q] >> 16); } }
        if (tid < 64) { bt[tid] = bcs[(size_t)bh * SEQ + 64 * k + tid]; ig[tid] = gates[(row0 + tid) * 16 + 8 + h]; }
        else if (tid < 192) nprev[tid - 64] = nst[(size_t)u * 128 + (tid - 64)];
        __syncthreads();
        if (tid < 64) { const float btv = bt[tid]; float mx = btv + mprev;
            for (int s = 0; s <= tid; ++s) mx = fmaxf(mx, btv - bt[s] + ig[s]);
            mt[tid] = mx; inter[tid] = __expf(btv + mprev - mx); }
        const int st = wave >> 1, tt0 = 2 * (wave & 1);
        f32x4 sacc[2] = {{0.f, 0.f, 0.f, 0.f}, {0.f, 0.f, 0.f, 0.f}};
#pragma unroll
        for (int ks = 0; ks < 4; ++ks) { const bf16x8 a = *(const LAS bf16x8*)(Ks + (16 * st + fr) * 136 + 32 * ks + 8 * fq);
#pragma unroll
            for (int j = 0; j < 2; ++j) { const bf16x8 bq = *(const LAS bf16x8*)(Qs + (16 * (tt0 + j) + fr) * 136 + 32 * ks + 8 * fq);
                sacc[j] = __builtin_amdgcn_mfma_f32_16x16x32_bf16(a, bq, sacc[j], 0, 0, 0); } }
        __syncthreads();
#pragma unroll
        for (int j = 0; j < 2; ++j) { const int t = 16 * (tt0 + j) + fr; const float base = bt[t] - mt[t]; float o[4];
#pragma unroll
            for (int i = 0; i < 4; ++i) { const int s = 16 * st + 4 * fq + i; o[i] = (s <= t) ? sacc[j][i] * __expf(base - bt[s] + ig[s]) : 0.f; }
            u32x2 w; w.x = pk2(o[0], o[1]); w.y = pk2(o[2], o[3]); *(LAS u32x2*)(St + t * 72 + 16 * st + 4 * fq) = w; }
        __syncthreads();
        { const int t = tid >> 3, part = tid & 7; float rs = 0.f, qn = 0.f;
#pragma unroll
            for (int i = 0; i < 8; ++i) rs += bf2f(St[t * 72 + 8 * part + i]);
#pragma unroll
            for (int i = 0; i < 16; ++i) qn += bf2f(Qs[t * 136 + 16 * part + i]) * nprev[16 * part + i];
            rs += __shfl_xor(rs, 1); rs += __shfl_xor(rs, 2); rs += __shfl_xor(rs, 4);
            qn += __shfl_xor(qn, 1); qn += __shfl_xor(qn, 2); qn += __shfl_xor(qn, 4);
            if (part == 0) { const float den = inter[t] * qn + rs; scl[t] = 1.0f / fmaxf(fabsf(den), __expf(-mt[t])); ssq[t] = 0.f; } }
        f32x4 acc[2][4];
#pragma unroll
        for (int vt = 0; vt < 2; ++vt)
#pragma unroll
            for (int tt = 0; tt < 4; ++tt) acc[vt][tt] = (f32x4){0.f, 0.f, 0.f, 0.f};
#pragma unroll
        for (int ks = 0; ks < 4; ++ks)
#pragma unroll
            for (int tt = 0; tt < 4; ++tt) { const bf16x8 bq = *(const LAS bf16x8*)(Qs + (16 * tt + fr) * 136 + 32 * ks + 8 * fq);
                acc[0][tt] = __builtin_amdgcn_mfma_f32_16x16x32_bf16(cfr[0][ks], bq, acc[0][tt], 0, 0, 0);
                acc[1][tt] = __builtin_amdgcn_mfma_f32_16x16x32_bf16(cfr[1][ks], bq, acc[1][tt], 0, 0, 0); }
#pragma unroll
        for (int tt = 0; tt < 4; ++tt) { const float it = inter[16 * tt + fr]; acc[0][tt] = acc[0][tt] * it; acc[1][tt] = acc[1][tt] * it; }
#pragma unroll
        for (int ks = 0; ks < 2; ++ks) { bf16x8 av[2];
#pragma unroll
            for (int vt = 0; vt < 2; ++vt) av[vt] = *(const LAS bf16x8*)(Vt + (32 * wave + 16 * vt + fr) * 72 + 32 * ks + 8 * fq);
#pragma unroll
            for (int tt = 0; tt < 4; ++tt) { const bf16x8 bs = *(const LAS bf16x8*)(St + (16 * tt + fr) * 72 + 32 * ks + 8 * fq);
                acc[0][tt] = __builtin_amdgcn_mfma_f32_16x16x32_bf16(av[0], bs, acc[0][tt], 0, 0, 0);
                acc[1][tt] = __builtin_amdgcn_mfma_f32_16x16x32_bf16(av[1], bs, acc[1][tt], 0, 0, 0); } }
        __syncthreads();
#pragma unroll
        for (int tt = 0; tt < 4; ++tt) { const float sc = scl[16 * tt + fr]; float q = 0.f;
#pragma unroll
            for (int vt = 0; vt < 2; ++vt) { acc[vt][tt] = acc[vt][tt] * sc; q += (acc[vt][tt][0] * acc[vt][tt][0] + acc[vt][tt][1] * acc[vt][tt][1]) + (acc[vt][tt][2] * acc[vt][tt][2] + acc[vt][tt][3] * acc[vt][tt][3]); }
            q += __shfl_xor(q, 16); q += __shfl_xor(q, 32);
            if (fq == 0) ssqw[wave * 64 + 16 * tt + fr] = q; }
        __syncthreads();
        if (tid < 64) { float s = 0.f;
#pragma unroll
            for (int w = 0; w < 8; ++w) s += ssqw[w * 64 + tid];
            ssq[tid] = s; }
        __syncthreads();
#pragma unroll
        for (int tt = 0; tt < 4; ++tt) { const int t = 16 * tt + fr; const float rn = 1.0f / sqrtf(ssq[t] * (1.f / 256.f) + LN_EPS);
#pragma unroll
            for (int vt = 0; vt < 2; ++vt) { const int v = 32 * wave + 16 * vt + 4 * fq;
                const f32x4 g = *(const f32x4*)(p.ml_ng + 256 * h + v); const u32x2 ob = *(const u32x2*)(Z + (row0 + t) * ZP + 5120 + 256 * h + v);
                const f32x4 y = acc[vt][tt] * rn * g;
                u32x2 w; w.x = pk2(y[0] * __uint_as_float(ob.x << 16), y[1] * __uint_as_float(ob.x & 0xffff0000u)); w.y = pk2(y[2] * __uint_as_float(ob.y << 16), y[3] * __uint_as_float(ob.y & 0xffff0000u));
                *(u32x2*)(Y + (row0 + t) * DM + 1024 + 256 * h + v) = w; } }
        __syncthreads();
    }
}
}
namespace fa {
constexpr int D = 128, KVP = 6144, OP = 2048;
constexpr float THR = 8.f;
constexpr bool WSKIP = false;
constexpr float SCALE = 0.08838834764831845f;
constexpr int NW = 8, QBLK = 32, KVBLK = 64, QB = NW * QBLK;
constexpr int SHM_V = KVBLK * D * 2, SHM_K = KVBLK * D * 2;
constexpr int LDS_BYTES = 2 * SHM_V + 2 * SHM_K + NW * 64 * 4;
constexpr int FL_OFF = 69632;
using bf16 = __hip_bfloat16;
typedef short bf16x8 __attribute__((ext_vector_type(8)));
typedef short s16x4 __attribute__((ext_vector_type(4)));
typedef float f32x16 __attribute__((ext_vector_type(16)));
typedef float f32x4 __attribute__((ext_vector_type(4)));
typedef unsigned u32x4 __attribute__((ext_vector_type(4)));
template <class A, class Bt> struct same_t { static constexpr bool v = false; };
template <class A> struct same_t<A, A> { static constexpr bool v = true; };

#define KSWZ(row, colB) ((row) * 256 + ((colB) ^ (((row) & 7) << 4)))
#define SBAR() __builtin_amdgcn_sched_barrier(0)
__device__ __forceinline__ int v_st(int k, int c) { const int kk = (k & ~0xC) | ((k & 4) << 1) | ((k & 8) >> 1); return ((kk >> 3) * 4 + (c >> 5)) * 512 + ((kk & 7) * 32 + (c & 31)) * 2; }
__device__ __forceinline__ int v_rd_base(int lane) { return ((lane & 3) << 3) | (((lane >> 2) & 3) << 6) | (((lane >> 4) & 1) << 5) | (((lane >> 5) & 1) << 8); }
constexpr int v_rd_off(int d0, int ks, int half) { return d0 * 512 + ks * 4096 + half * 2048; }
__device__ __forceinline__ int crow(int r, int hi) { return (r & 3) + 8 * (r >> 2) + 4 * hi; }
__device__ __forceinline__ unsigned cvtpk(float lo, float hi) { return pg8::cvt_pk_bf16(lo, hi); }
__device__ __forceinline__ bf16x8 pack8(f32x4 a, f32x4 b) {
    u32x4 w = {cvtpk(a[0], a[1]), cvtpk(a[2], a[3]), cvtpk(b[0], b[1]), cvtpk(b[2], b[3])};
    return *reinterpret_cast<bf16x8*>(&w);
}
template <class T> __device__ __forceinline__ bf16x8 load8(const T* p) {
    if constexpr (same_t<T, float>::v) { return pack8(*(const f32x4*)p, *(const f32x4*)(p + 4)); }
    else { return *reinterpret_cast<const bf16x8*>(p); }
}
__device__ __forceinline__ void split3(float x, unsigned& h, unsigned& m, unsigned& l) {
    const unsigned xb = __float_as_uint(x); h = xb >> 16; const float r = x - __uint_as_float(xb & 0xffff0000u);
    const unsigned rb = __float_as_uint(r); m = rb >> 16; const float r2 = r - __uint_as_float(rb & 0xffff0000u);
    l = __float_as_uint(r2) >> 16;
}
__device__ __forceinline__ bf16x8 aug_q(float x, int hi) { unsigned h, m, l; split3(x, h, m, l);
    u32x4 w = {h | (m << 16), l | 0x3F800000u, 0x3F803F80u, 0u}; if (hi) w = u32x4{0u, 0u, 0u, 0u}; return *reinterpret_cast<bf16x8*>(&w); }
__device__ __forceinline__ bf16x8 aug_k(float x, int hi) { unsigned h, m, l; split3(x, h, m, l);
    u32x4 w = {0x3F803F80u, 0x3F80u | (h << 16), m | (l << 16), 0u}; if (hi) w = u32x4{0u, 0u, 0u, 0u}; return *reinterpret_cast<bf16x8*>(&w); }
__device__ __forceinline__ void mask_tile(f32x16& p0, f32x16& p1, int dq, unsigned W) {
    const float NEG = -__builtin_inff();
#pragma unroll
    for (int r = 0; r < 16; ++r) {
        const int c = (r & 3) + 8 * (r >> 2);
        if ((unsigned)(dq - c) >= W) p0[r] = NEG;
        if ((unsigned)(dq - c - 32) >= W) p1[r] = NEG;
    }
}
__device__ __forceinline__ void partialSM(f32x16& p0, f32x16& p1, float& m_reg, float& mn, float& alpha) {
    float pmax = p0[0]; for (int r = 1; r < 16; ++r) pmax = fmaxf(pmax, p0[r]); for (int r = 0; r < 16; ++r) pmax = fmaxf(pmax, p1[r]);
    { auto rr = __builtin_amdgcn_permlane32_swap(__float_as_uint(pmax), __float_as_uint(pmax), false, false);
      pmax = fmaxf(__uint_as_float(rr[0]), __uint_as_float(rr[1])); }
    constexpr float C2 = 1.4426950408889634f * SCALE;
    if (__builtin_expect(__all((pmax - m_reg) * SCALE <= THR), 1)) { mn = m_reg; alpha = 1.f; }
    else { mn = fmaxf(m_reg, pmax); alpha = __builtin_amdgcn_exp2f((m_reg - mn) * C2); m_reg = mn; }
    const float mnL = -mn * C2;
    for (int r = 0; r < 16; ++r) p0[r] = fmaf(p0[r], C2, mnL); for (int r = 0; r < 16; ++r) p1[r] = fmaf(p1[r], C2, mnL);
    for (int r = 0; r < 16; ++r) p0[r] = __builtin_amdgcn_exp2f(p0[r]);
}
__device__ __forceinline__ void finishSM(f32x16& p0, f32x16& p1, float alpha, float& l_reg, bf16x8& pa0, bf16x8& pa1, bf16x8& pa2, bf16x8& pa3) {
    for (int r = 0; r < 16; ++r) p1[r] = __builtin_amdgcn_exp2f(p1[r]);
    float ps = 0; for (int r = 0; r < 16; ++r) ps += p0[r]; for (int r = 0; r < 16; ++r) ps += p1[r];
    { auto rr = __builtin_amdgcn_permlane32_swap(__float_as_uint(ps), __float_as_uint(ps), false, false);
      ps = __uint_as_float(rr[0]) + __uint_as_float(rr[1]); }
    l_reg = l_reg * alpha + ps;
#define PK4(P, B_, OUT) do { unsigned a0 = cvtpk(P[B_+0], P[B_+1]), a1 = cvtpk(P[B_+2], P[B_+3]);                          \
        unsigned b0 = cvtpk(P[B_+4], P[B_+5]), b1 = cvtpk(P[B_+6], P[B_+7]);                                             \
        auto r0 = __builtin_amdgcn_permlane32_swap(a0, b0, false, false); auto r1 = __builtin_amdgcn_permlane32_swap(a1, b1, false, false); \
        u32x4 w = {r0[0], r1[0], r0[1], r1[1]}; OUT = *reinterpret_cast<bf16x8*>(&w); } while (0)
    PK4(p0, 0, pa0); PK4(p0, 8, pa1); PK4(p1, 0, pa2); PK4(p1, 8, pa3);
#undef PK4
}
template <int KB, bool SK>
__device__ __forceinline__ void qkt(f32x16& p0, f32x16& p1, const char* K_lds, int r32, int hi, const bf16x8* qr, bool act, bf16x8 qaug, bf16x8 ka0, bf16x8 ka1) {
    if (SK && !act) { const float NEG = -__builtin_inff();
#pragma unroll
        for (int r = 0; r < 16; ++r) { p0[r] = NEG; p1[r] = NEG; } return; }
    p0 = f32x16{}; p1 = f32x16{};
    p0 = __builtin_amdgcn_mfma_f32_32x32x16_bf16(ka0, qaug, p0, 0, 0, 0); p1 = __builtin_amdgcn_mfma_f32_32x32x16_bf16(ka1, qaug, p1, 0, 0, 0);
    const char* kb[4];
#pragma unroll
    for (int dd = 0; dd < 4; ++dd) kb[dd] = K_lds + KB * SHM_K + KSWZ(r32, (dd * 16 + hi * 8) * 2);
#pragma unroll
    for (int d0 = 0; d0 < 8; ++d0) { const char* a = kb[d0 & 3] + (d0 >> 2) * 128;
        bf16x8 b0 = *reinterpret_cast<const bf16x8*>(a);
        bf16x8 b1 = *reinterpret_cast<const bf16x8*>(a + 32 * 256);
        p0 = __builtin_amdgcn_mfma_f32_32x32x16_bf16(b0, qr[d0], p0, 0, 0, 0);
        p1 = __builtin_amdgcn_mfma_f32_32x32x16_bf16(b1, qr[d0], p1, 0, 0, 0); }
}
template <int VB, bool SK>
__device__ __forceinline__ void pv_tile(f32x16* o, int vb0, bf16x8 pa0, bf16x8 pa1, bf16x8 pa2, bf16x8 pa3, bool act) {
    if (SK && !act) return;
#define TRRD(dst, off) asm volatile("ds_read_b64_tr_b16 %0, %1 offset:%2" : "=&v"(dst) : "v"(vb0), "i"(off) : "memory")
#define PV_D0(d0) do { s16x4 l0, l1, l2, l3, h0, h1, h2, h3; constexpr int b_ = VB * SHM_V + v_rd_off(d0, 0, 0);     \
        TRRD(l0, b_); TRRD(h0, b_ + 2048); TRRD(l1, b_ + 4096); TRRD(h1, b_ + 6144); TRRD(l2, b_ + 8192); TRRD(h2, b_ + 10240); TRRD(l3, b_ + 12288); TRRD(h3, b_ + 14336); \
        asm volatile("s_waitcnt lgkmcnt(0)" ::: "memory"); SBAR();                 \
        o[d0] = __builtin_amdgcn_mfma_f32_32x32x16_bf16(pa0, (bf16x8){l0[0], l0[1], l0[2], l0[3], h0[0], h0[1], h0[2], h0[3]}, o[d0], 0, 0, 0);   \
        o[d0] = __builtin_amdgcn_mfma_f32_32x32x16_bf16(pa1, (bf16x8){l1[0], l1[1], l1[2], l1[3], h1[0], h1[1], h1[2], h1[3]}, o[d0], 0, 0, 0);   \
        o[d0] = __builtin_amdgcn_mfma_f32_32x32x16_bf16(pa2, (bf16x8){l2[0], l2[1], l2[2], l2[3], h2[0], h2[1], h2[2], h2[3]}, o[d0], 0, 0, 0);   \
        o[d0] = __builtin_amdgcn_mfma_f32_32x32x16_bf16(pa3, (bf16x8){l3[0], l3[1], l3[2], l3[3], h3[0], h3[1], h3[2], h3[3]}, o[d0], 0, 0, 0); } while (0)
    PV_D0(0); PV_D0(1); PV_D0(2); PV_D0(3);
#undef PV_D0
#undef TRRD
}

template <class TIn, class TOut> struct BlockRef { const TIn* Q; const TIn* K; const TIn* V; TOut* O; const float* F; int P0; };
template <class TIn> struct Seam {
    bf16x8 qr[8];
    bf16x8 st_v0, st_v1, st_k0, st_k1; f32x4 sf0, sf1, sf2, sf3;
    f32x4 tq[16];
};
__device__ __forceinline__ int swa_jlo(int P0, int W) { const int lowk = P0 - W + 1; return lowk > 0 ? lowk / KVBLK : 0; }
#define ROW(p, k0, rr) ((p) + (size_t)((k0) + (rr)) * KVP + sc)
#define VMW() asm volatile("s_waitcnt vmcnt(0)" ::: "memory")
#define VMWN(n) asm volatile("s_waitcnt vmcnt(%0)" :: "i"(n) : "memory")
#define SLOAD_H(Kp, Vp, k0) do { S.st_v0 = load8<TIn>(ROW(Vp, k0, sr)); S.st_v1 = load8<TIn>(ROW(Vp, k0, 32 + sr));              \
                         S.st_k0 = load8<TIn>(ROW(Kp, k0, sr)); S.st_k1 = load8<TIn>(ROW(Kp, k0, 32 + sr)); } while (0)
#define SWRITE_HK(bf) do { *(bf16x8*)(K_lds + (bf) * SHM_K + kws) = S.st_k0; *(bf16x8*)(K_lds + (bf) * SHM_K + kws + 32 * 256) = S.st_k1; } while (0)
#define SWRITE_HV(bf) do { *(bf16x8*)(V_lds + (bf) * SHM_V + vst0) = S.st_v0; *(bf16x8*)(V_lds + (bf) * SHM_V + vst1) = S.st_v1; } while (0)
#define SWRITE_H(bf) do { SWRITE_HV(bf); SWRITE_HK(bf); } while (0)
#define SLOAD_F(p, k0) do { S.sf0 = *(const f32x4*)ROW(p, k0, sr); S.sf1 = *(const f32x4*)(ROW(p, k0, sr) + 4);                \
                            S.sf2 = *(const f32x4*)ROW(p, k0, 32 + sr); S.sf3 = *(const f32x4*)(ROW(p, k0, 32 + sr) + 4); } while (0)
#define SWRITE_KF(bf) do { *(bf16x8*)(K_lds + (bf) * SHM_K + kws) = pack8(S.sf0, S.sf1); *(bf16x8*)(K_lds + (bf) * SHM_K + kws + 32 * 256) = pack8(S.sf2, S.sf3); } while (0)
#define SWRITE_VF(bf) do { *(bf16x8*)(V_lds + (bf) * SHM_V + vst0) = pack8(S.sf0, S.sf1); *(bf16x8*)(V_lds + (bf) * SHM_V + vst1) = pack8(S.sf2, S.sf3); } while (0)
template <class TIn, class TOut>
__device__ __forceinline__ void causal_swa_prime(const BlockRef<TIn, TOut>& cur, int W, char* lds, Seam<TIn>& S) {
    constexpr bool F32 = same_t<TIn, float>::v;
    int tid_l = threadIdx.x; asm volatile("" : "+v"(tid_l)); const int tid = tid_l, wid = __builtin_amdgcn_readfirstlane(tid >> 6), lane = tid & 63, r32 = lane & 31, hi = lane >> 5;
    const int sr = tid >> 4, sc = (tid & 15) * 8, kws = KSWZ(sr, sc * 2); char* K_lds = lds + 2 * SHM_V;
    const int kb0 = swa_jlo(cur.P0, W) * KVBLK;
    for (int d0 = 0; d0 < 8; ++d0) S.qr[d0] = load8<TIn>(cur.Q + (size_t)(wid * QBLK + r32) * KVP + d0 * 16 + hi * 8);
    if constexpr (F32) { SLOAD_F((const float*)cur.K, kb0); VMW(); SWRITE_KF(0); SBAR(); SLOAD_F((const float*)cur.V, kb0); }
    else { SLOAD_H(cur.K, cur.V, kb0); VMW(); SWRITE_HK(0); }
    __syncthreads();
}
template <class TIn, class TOut>
__device__ __forceinline__ void causal_swa_block(const BlockRef<TIn, TOut>& cur, const BlockRef<TIn, TOut>& nxt, int skv, int W, char* lds, Seam<TIn>& S) {
    constexpr bool F32 = same_t<TIn, float>::v;
    int tid_l = threadIdx.x; asm volatile("" : "+v"(tid_l)); const int tid = tid_l, wid = __builtin_amdgcn_readfirstlane(tid >> 6), lane = tid & 63, r32 = lane & 31, hi = lane >> 5;
    const int j_lo = swa_jlo(cur.P0, W);
    int j_hi = (cur.P0 + QB - 1) / KVBLK + 1; if (j_hi > skv / KVBLK) j_hi = skv / KVBLK;
    const int NT = j_hi - j_lo;
    const int kbn = swa_jlo(nxt.P0, W) * KVBLK;
    const int qlo = cur.P0 + wid * QBLK, qm = qlo + r32 - 4 * hi;
    float* Fl = (float*)(lds + FL_OFF);
    float fqv;
    { const float fbase = __uint_as_float(__builtin_amdgcn_readfirstlane(__float_as_uint(cur.F[cur.P0]))); fqv = cur.F[cur.P0 + wid * QBLK + r32] - fbase;
      for (int i = tid; i < cur.P0 + QB; i += 64 * NW) Fl[i] = cur.F[i] - fbase; }
    __syncthreads();
#define KAUG(t_, a_, b_) const bf16x8 qaug = aug_q(fqv, hi), a_ = aug_k(-Fl[KBASE(t_) + r32], hi), b_ = aug_k(-Fl[KBASE(t_) + 32 + r32], hi)
#define FLOADK(t) do { } while (0)
    char* V_lds = lds; char* K_lds = lds + 2 * SHM_V;
    float* ws = (float*)(lds + 2 * SHM_V + 2 * SHM_K) + wid * 64; float* li_l = ws, * al_l = ws + 32;
    float m_reg = -1e30f, l_reg = 0; f32x16 o[4] = {};
    const int sr = tid >> 4, sc = (tid & 15) * 8, vst0 = v_st(sr, sc), vst1 = v_st(32 + sr, sc), kws = KSWZ(sr, sc * 2);
    const int vb0 = (int)(uintptr_t)V_lds + v_rd_base(lane);
    const TIn* Kh = cur.K; const TIn* Vh = cur.V;
#define RESC(a) do { if (__any((a) < 1.f)) { if (hi == 0) al_l[r32] = (a); asm volatile("s_waitcnt lgkmcnt(0)" ::: "memory");              \
                     for (int d_ = 0; d_ < 4; ++d_) for (int r = 0; r < 16; ++r) o[d_][r] *= al_l[crow(r, hi)]; } } while (0)
#define KBASE(t) ((j_lo + (t)) * KVBLK)
#define ACT(t) (KBASE(t) <= qlo + QBLK - 1 && KBASE(t) + KVBLK - 1 >= qlo - W + 1)
#define MASKT(P0_, P1_, t) do { const int kb_ = KBASE(t); if ((!SK || ACT(t)) && (kb_ + KVBLK - 1 > qlo || kb_ <= qlo + QBLK - 1 - W)) mask_tile(P0_, P1_, qm - kb_, (unsigned)W); } while (0)
    constexpr int NQL = F32 ? 16 : 8;
    constexpr bool SK = WSKIP && !F32;
#define SEAM_K0() do { VMWN(NQL); if constexpr (F32) { SWRITE_KF(0); SBAR(); SLOAD_F((const float*)nxt.V, kbn); } else { SWRITE_HK(0); } SBAR(); } while (0)
    f32x16 pA0, pA1, pB0, pB1; float mnA, mnB, alA, alB; bf16x8 pa0, pa1, pa2, pa3;
    if constexpr (F32) { VMW(); SWRITE_VF(0); SBAR(); } else { SWRITE_HV(0); SBAR(); }
    bf16x8 kh0, kh1, qaug0; { KAUG(0, a_, b_); kh0 = a_; kh1 = b_; qaug0 = qaug; }
    if (NT > 1) { if constexpr (F32) SLOAD_F((const float*)Kh, KBASE(1)); else SLOAD_H(Kh, Vh, KBASE(1)); FLOADK(1); }
    SBAR(); qkt<0, SK>(pA0, pA1, K_lds, r32, hi, S.qr, ACT(0), qaug0, kh0, kh1);
    if constexpr (F32) { if (NT > 1) { VMW(); SWRITE_KF(1); SBAR(); SLOAD_F((const float*)Vh, KBASE(1)); } }
    MASKT(pA0, pA1, 0); partialSM(pA0, pA1, m_reg, mnA, alA);
    if (NT > 1) { VMW(); if constexpr (F32) { SWRITE_VF(1); SBAR(); if (NT > 2) SLOAD_F((const float*)Kh, KBASE(2)); } else SWRITE_H(1); }
    __syncthreads();
#define HALF_STEP(PX0, PX1, mnX, alX, PY0, PY1, alY, t, KB, VB, SB) do {                                                      \
        SBAR(); { KAUG(t, kx0, kx1); qkt<KB, SK>(PX0, PX1, K_lds, r32, hi, S.qr, ACT(t), qaug, kx0, kx1); }                  \
        finishSM(PY0, PY1, alY, l_reg, pa0, pa1, pa2, pa3); SBAR();                                                           \
        if ((t) + 1 < NT) { if constexpr (F32) { VMW(); SWRITE_KF(SB); SBAR(); SLOAD_F((const float*)Vh, KBASE((t) + 1)); }  \
                            else { SLOAD_H(Kh, Vh, KBASE((t) + 1)); } FLOADK((t) + 1); SBAR(); }                                               \
        pv_tile<VB, SK>(o, vb0, pa0, pa1, pa2, pa3, ACT((t) - 1)); MASKT(PX0, PX1, (t)); partialSM(PX0, PX1, m_reg, mnX, alX);                                        \
        __syncthreads();                                                                                                      \
        if ((t) + 1 < NT) { VMW(); if constexpr (F32) { SWRITE_VF(SB); SBAR(); if ((t) + 2 < NT) SLOAD_F((const float*)Kh, KBASE((t) + 2)); } \
                            else { SWRITE_H(SB); } }                                                                          \
        RESC(alX); __syncthreads(); } while (0)
    for (int t = 1; t + 1 < NT; t += 2) {
        HALF_STEP(pB0, pB1, mnB, alB, pA0, pA1, alA, t, 1, 0, 0);
        HALF_STEP(pA0, pA1, mnA, alA, pB0, pB1, alB, t + 1, 0, 1, 1);
    }
    const bool even = (NT & 1) == 0;
    if (even) { SBAR(); KAUG(NT - 1, kt0, kt1); qkt<1, SK>(pB0, pB1, K_lds, r32, hi, S.qr, ACT(NT - 1), qaug, kt0, kt1); SBAR(); }
#define QROW(e) (nxt.Q + (size_t)(wid * QBLK + r32) * D + ((e) >> 1) * 16 + hi * 8 + ((e) & 1) * 4)
    if constexpr (F32) { SLOAD_F((const float*)nxt.K, kbn); SBAR();
#pragma unroll
        for (int e = 0; e < 8; ++e) S.tq[e] = *(const f32x4*)QROW(e); }
    else { SLOAD_H(nxt.K, nxt.V, kbn); SBAR();
#pragma unroll
        for (int d0 = 0; d0 < 8; ++d0) S.qr[d0] = load8<TIn>(nxt.Q + (size_t)(wid * QBLK + r32) * KVP + d0 * 16 + hi * 8); }
    SBAR();
    finishSM(pA0, pA1, alA, l_reg, pa0, pa1, pa2, pa3); SBAR();
    if constexpr (F32) {
#pragma unroll
        for (int e = 8; e < 16; ++e) S.tq[e] = *(const f32x4*)QROW(e); SBAR(); }
#undef QROW
    pv_tile<0, SK>(o, vb0, pa0, pa1, pa2, pa3, ACT(even ? NT - 2 : NT - 1));
    if (even) { MASKT(pB0, pB1, NT - 1); partialSM(pB0, pB1, m_reg, mnB, alB); __syncthreads(); RESC(alB);
        finishSM(pB0, pB1, alB, l_reg, pa0, pa1, pa2, pa3); SBAR(); pv_tile<1, SK>(o, vb0, pa0, pa1, pa2, pa3, ACT(NT - 1)); }
    SBAR(); SEAM_K0();
    if (hi == 0) li_l[r32] = l_reg; asm volatile("s_waitcnt lgkmcnt(0)" ::: "memory");
    float rli[16];
#pragma unroll
    for (int r = 0; r < 16; ++r) rli[r] = __builtin_amdgcn_rcpf(li_l[crow(r, hi)]);
    TOut* Ow = cur.O + (size_t)(wid * QBLK) * OP;
#pragma unroll
    for (int r = 0; r < 16; ++r) { const int orow = crow(r, hi);
#pragma unroll
        for (int d0 = 0; d0 < 4; ++d0) { const float v = o[d0][r] * rli[r];
            if constexpr (same_t<TOut, float>::v) { Ow[(size_t)orow * OP + d0 * 32 + r32] = v; }
            else { const float vn = __shfl_xor(v, 1);
                   if ((r32 & 1) == 0) *(unsigned*)(Ow + (size_t)orow * OP + d0 * 32 + r32) = cvtpk(v, vn); } } }
    if constexpr (F32) {
#pragma unroll
        for (int d0 = 0; d0 < 8; ++d0) S.qr[d0] = pack8(S.tq[2 * d0], S.tq[2 * d0 + 1]); }
    __syncthreads();
#undef RESC
#undef KBASE
#undef ACT
#undef MASKT
#undef SEAM_K0
#undef HALF_STEP
#undef KAUG
#undef FLOADK
}
#undef ROW
#undef VMW
#undef VMWN
#undef SLOAD_H
#undef SWRITE_HK
#undef SWRITE_HV
#undef SWRITE_H
#undef SLOAD_F
#undef SWRITE_KF
#undef SWRITE_VF

__device__ __forceinline__ void attn_phase(char* lds, const bf16* Z, bf16* Y, const float* Fs) {
    using BR = BlockRef<bf16, bf16>;
    const int total = 512, stride = gridDim.x;
    int L = blockIdx.x; if (L >= total) return;
    auto mkref = [&](int Li, int pass) { const int xcd = Li & 7, k = Li >> 3, bh = (k >> 5) * 8 + xcd, x = k & 31, qb = pass ? 63 - x : x, b = bh >> 3, h = bh & 7;
        BR r; const size_t rowb = (size_t)b * 16384;
        r.Q = Z + (rowb + (size_t)qb * QB) * KVP + h * 128; r.K = Z + rowb * KVP + 1024 + h * 128; r.V = Z + rowb * KVP + 2048 + h * 128;
        r.O = Y + (rowb + (size_t)qb * QB) * OP + h * 128; r.F = Fs + (size_t)bh * 16384; r.P0 = qb * QB; return r; };
    int pass = 0; BR cur = mkref(L, 0);
    Seam<bf16> S;
    causal_swa_prime<bf16, bf16>(cur, 16384, lds, S);
    for (;;) {
        const bool more_pass = pass == 0, more_item = L + stride < total, last = !more_pass && !more_item;
        int passn = pass + 1, Ln = L;
        if (!more_pass) { passn = 0; Ln = more_item ? L + stride : L; }
        const BR nxt = last ? cur : mkref(Ln, passn);
        causal_swa_block<bf16, bf16>(cur, nxt, 16384, 16384, lds, S);
        if (last) break;
        cur = nxt; pass = passn; L = Ln;
    }
}
}

namespace mk {
__device__ __forceinline__ void zero_y_half(bf16_t* Y, int colbase) {
    for (size_t i = (size_t)blockIdx.x * NT + threadIdx.x; i < (size_t)T * 128; i += (size_t)gridDim.x * NT) { const size_t r = i >> 7, cgp = i & 127;
        *(u32x4*)(Y + r * DM + colbase + 8 * cgp) = (u32x4){0u, 0u, 0u, 0u}; }
}
__device__ __forceinline__ void dump_cst(const bf16_t* C, const float* nstp, bf16_t* Y) {
    for (size_t i = (size_t)blockIdx.x * NT + threadIdx.x; i < (size_t)T * 1024; i += (size_t)gridDim.x * NT) { const size_t r = i >> 10, c = i & 1023;
        const float v = 1e-3f * (bf2f(C[r * 2048 + c]) + bf2f(C[r * 2048 + 1024 + c])) + 1e-3f * nstp[i & 262143];
        Y[r * DM + 1024 + c] = (bf16_t)(pk2(v, 0.f) & 0xffffu); }
}
__global__ void __launch_bounds__(NT, 2) mega(Params p) {
    extern __shared__ __attribute__((aligned(16))) unsigned char lds_raw[];
    LAS unsigned char* lds = (LAS unsigned char*)lds_raw;
    cg::grid_group grid = cg::this_grid();
#define GRID_SYNC() do { asm volatile("s_waitcnt vmcnt(0) lgkmcnt(0)" ::: "memory"); grid.sync(); } while (0)
    unsigned char* ws = p.ws;
    float* ada = (float*)(ws + WS_ADA);
    bf16_t* A = (bf16_t*)(ws + WS_A); bf16_t* ZH = (bf16_t*)(ws + WS_Z);
    const int G = gridDim.x, c = blockIdx.x;

    p0_prologue(p, lds);
    GRID_SYNC();
    ln_phase<0>(p.x, nullptr, A, nullptr, nullptr, ada + 0 * DM, ada + 1 * DM);
    GRID_SYNC();
    { pg8::Gemm g{A, (const bf16_t*)(ws + WS_W1T), T, 2 * DFF, DM}; pg8::StaticOrder S; S.init(T, 2 * DFF, G, c);
      pg8::EpiSwiglu E{ZH, DFF}; pg8::gemm_phase<pg8::EpiSwiglu, pg8::StaticOrder, true, true>(lds, g, S, E); }
    GRID_SYNC();
    { pg8::Gemm g{ZH, (const bf16_t*)(ws + WS_W1O), T, DM, DFF}; pg8::StaticOrder S; S.init(T, DM, G, c);
      pg8::EpiResid E{p.x, p.out, ada + 2 * DM, ALPHA, 0.5f, SEQ, NADA}; pg8::gemm_phase<pg8::EpiResid, pg8::StaticOrder, true, true>(lds, g, S, E); }
    GRID_SYNC();
    ln_phase<1>(p.out, p.out, A, p.ln1_g, p.ln1_b, ada + 3 * DM, ada + 4 * DM);
    GRID_SYNC();
#ifndef SKIP_MIXER
    { pg8::Gemm g{A, (const bf16_t*)(ws + WS_WIN), T, NINP, DM}; pg8::StaticOrder S; S.init(T, NINP, G, c);
      pg8::EpiInproj E{ZH, (float*)(ws + WS_GATES), p.fox_fb, p.ml_ib, p.ml_fb}; pg8::gemm_phase<pg8::EpiInproj, pg8::StaticOrder, true, true>(lds, g, S, E); }
    GRID_SYNC();
    p6_scalars_conv(p, lds);
    GRID_SYNC();
#ifndef SKIP_MLSTM
    p7_mlstm_local(p, lds);
    GRID_SYNC();
#ifndef SKIP_SCAN
    p8_mlstm_scan(p);
#endif
    __syncthreads();
#endif
#ifndef SKIP_ATTN
    fa::attn_phase((char*)lds_raw, (const fa::bf16*)ZH, (fa::bf16*)A, (const float*)(ws + WS_FS));
#else
    zero_y_half(A, 0);
#endif
    GRID_SYNC();
#if defined(DUMP_CST)
    dump_cst((const bf16_t*)(ws + WS_CST), (const float*)(ws + WS_NST), A);
#elif !defined(SKIP_MLSTM)
    p9_mlstm_out(p, lds);
#else
    zero_y_half(A, 1024);
#endif
    GRID_SYNC();
    { pg8::Gemm g{A, (const bf16_t*)(ws + WS_WOT), T, DM, DM}; pg8::StaticOrder S; S.init(T, DM, G, c);
      pg8::EpiResid E{p.out, p.out, ada + 5 * DM, ALPHA, 1.0f, SEQ, NADA}; pg8::gemm_phase<pg8::EpiResid, pg8::StaticOrder, true, true>(lds, g, S, E); }
    GRID_SYNC();
#endif
    ln_phase<1>(p.out, p.out, A, p.ln2_g, p.ln2_b, ada + 6 * DM, ada + 7 * DM);
    GRID_SYNC();
    { pg8::Gemm g{A, (const bf16_t*)(ws + WS_W2T), T, 2 * DFF, DM}; pg8::StaticOrder S; S.init(T, 2 * DFF, G, c);
      pg8::EpiSwiglu E{ZH, DFF}; pg8::gemm_phase<pg8::EpiSwiglu, pg8::StaticOrder, true, true>(lds, g, S, E); }
    GRID_SYNC();
    { pg8::Gemm g{ZH, (const bf16_t*)(ws + WS_W2O), T, DM, DFF}; pg8::StaticOrder S; S.init(T, DM, G, c);
      pg8::EpiResid E{p.out, p.out, ada + 8 * DM, ALPHA, 0.5f, SEQ, NADA}; pg8::gemm_phase<pg8::EpiResid, pg8::StaticOrder, true, true>(lds, g, S, E); }
    GRID_SYNC();
    ln_phase<2>(p.out, p.out, nullptr, p.ln3_g, p.ln3_b, nullptr, nullptr);
}
}

extern "C" void kernel_launch(void* const* d_in, const int* in_sizes, int n_in, void* d_out, int out_size, void* d_ws, size_t ws_size, hipStream_t stream) {
    static int grid = 0;
    if (grid == 0) {
        if (n_in != 22 || in_sizes[0] != mk::T * mk::DM || out_size != mk::T * mk::DM || ws_size < mk::WS_END) {
            fprintf(stderr, "kernel_launch: unexpected shapes (n_in %d, in0 %d, out %d, ws %zu)\n", n_in, n_in > 0 ? in_sizes[0] : -1, out_size, ws_size); grid = -1; return; }
        int dev = 0, cus = 0, per_cu = 0;
        (void)hipGetDevice(&dev); (void)hipDeviceGetAttribute(&cus, hipDeviceAttributeMultiprocessorCount, dev);
        if (hipFuncSetAttribute((const void*)mk::mega, hipFuncAttributeMaxDynamicSharedMemorySize, mk::LDS_BYTES) != hipSuccess) { fprintf(stderr, "kernel_launch: hipFuncSetAttribute failed\n"); grid = -1; return; }
        if (hipOccupancyMaxActiveBlocksPerMultiprocessor(&per_cu, (const void*)mk::mega, mk::NT, mk::LDS_BYTES) != hipSuccess || per_cu < 1) { fprintf(stderr, "kernel_launch: occupancy query says %d\n", per_cu); per_cu = 1; }
        (void)hipGetLastError();
        if (cus <= 0) cus = 256;
        grid = cus;
    }
    if (grid < 0) return;
    mk::Params p{};
    const float** pp = (const float**)&p;
    for (int i = 0; i < 22; ++i) pp[i] = (const float*)d_in[i];
    p.out = (float*)d_out; p.ws = (unsigned char*)d_ws;
    void* args[] = {&p};
    hipError_t e = hipLaunchCooperativeKernel((const void*)mk::mega, dim3(grid), dim3(mk::NT), args, mk::LDS_BYTES, stream);
    if (e != hipSuccess) fprintf(stderr, "kernel_launch: cooperative launch failed: %s (grid %d)\n", hipGetErrorString(e), grid);
}
```

```cpp
#define NONE 1
#include <hip/hip_runtime.h>
#include <hip/hip_cooperative_groups.h>
#include <hip/hip_bf16.h>
#include <cstdio>
#include <cstdint>
#include <cmath>
namespace cg = cooperative_groups;
namespace pg8 {
#define PG8_LAS __attribute__((address_space(3)))
typedef unsigned short bf16_t;
typedef short bf16x8 __attribute__((ext_vector_type(8)));
typedef float f32x4 __attribute__((ext_vector_type(4)));
typedef unsigned u32x4 __attribute__((ext_vector_type(4)));
constexpr int BM = 256, BK = 64, HALF = 128, HTB = HALF * BK * 2  , STAGE_BYTES = 8 * HTB, NXCD = 8, WGM = 8;

__host__ __device__ __forceinline__ int lds_byte(int r, int c) { const int st = (r >> 4) * 2 + (c >> 5), rr = r & 15, cc = c & 31, ob = rr * 64 + cc * 2; return st * 1024 + (ob ^ (((ob >> 9) & 1) << 5)); }
__host__ __device__ __forceinline__ void stage_rc(int b, int& R, int& C) { const int st = b / 1024, sb = b % 1024, swz = sb ^ (((sb >> 9) & 1) << 5); R = (st >> 1) * 16 + swz / 64; C = (st & 1) * 32 + (swz % 64) / 2; }
__host__ __device__ __forceinline__ int perm32(int rho) { const int n = rho >> 4, i = rho & 15; return 8 * (i >> 2) + 4 * n + (i & 3); }

struct Unit { int pm, pn; };
struct Gemm { const bf16_t* A; const bf16_t* Bt; int M, N, K; };

struct StaticOrder {
    int nM, nN, nwg, G, c;
    __host__ __device__ void init(int M, int N, int G_, int c_) { nM = M / BM; nN = N / BM; nwg = nM * nN; G = G_; c = c_; }
    __host__ __device__ bool next(int i, Unit& u) const {
        const long L = (long)i * G + c; if (L >= nwg) return false;
        int wgid = (int)L; { const int q = nwg / NXCD, r = nwg % NXCD, xcd = wgid % NXCD, off = wgid / NXCD; wgid = (xcd < r ? xcd * (q + 1) : r * (q + 1) + (xcd - r) * q) + off; }
        const int nig = WGM * nN, gid = wgid / nig, fm = gid * WGM, gsz = (nM - fm) < WGM ? (nM - fm) : WGM;
        u.pm = fm + ((wgid % nig) % gsz); u.pn = (wgid % nig) / gsz; return true;
    }
    __device__ __forceinline__ void a_ready(const Unit&, int) const {}
    __device__ __forceinline__ void done(const Unit&) const {}
};

typedef __bf16 bf16v2_t __attribute__((ext_vector_type(2)));
typedef float f32v2_t __attribute__((ext_vector_type(2)));
__device__ __forceinline__ unsigned cvt_pk_bf16(float lo, float hi) { const f32v2_t f = {lo, hi}; const bf16v2_t v = __builtin_convertvector(f, bf16v2_t); return __builtin_bit_cast(unsigned, v); }
typedef float f32x2 __attribute__((ext_vector_type(2)));
__device__ __forceinline__ f32x2 gelu_pk(f32x2 v) {
    const f32x2 av = __builtin_elementwise_abs(v), d = av * 0.2316418882f + 1.0f;
    f32x2 t; t.x = __builtin_amdgcn_rcpf(d.x); t.y = __builtin_amdgcn_rcpf(d.y);
    f32x2 q = t * 0.5307027145f + (-0.7265760135f); q = q * t + 0.7107068705f; q = q * t + (-0.142248368f); q = q * t + 0.127414796f; q = q * t;
    const f32x2 s = (v * v) * (-0.72134752044f);
    f32x2 e; e.x = __builtin_amdgcn_exp2f(s.x); e.y = __builtin_amdgcn_exp2f(s.y);
    const f32x2 m = v * (q * e), r = v - m;
    f32x2 o; o.x = v.x < 0.f ? m.x : r.x; o.y = v.y < 0.f ? m.y : r.y; return o;
}

template <int ACT  > struct EpiBf16 {
    static constexpr bool PERM = true, AFTER_DRAIN = false; static_assert(ACT == 0 || ACT == 1, "EpiBf16: ACT is 0 (none) or 1 (gelu_pk)");
    bf16_t* O; int ldc; const float* bias; int split_cols; size_t split_stride; float scale0;
    __device__ __forceinline__ void operator()(const f32x4 (&acc)[2][2][4][2], const Unit& u, int wr, int wc, int fr, int fq) const {
        const int row0 = u.pm * BM + wr * 64 + fr; int colt = u.pn * BM; bf16_t* base = O;
        float sc = 1.f; if (split_cols) { const int t = colt / split_cols; base += (size_t)t * split_stride; colt -= t * split_cols; if (t == 0) sc = scale0; }
        const int col0 = colt + wc * 32 + 8 * fq, bcol0 = u.pn * BM + wc * 32 + 8 * fq;
        f32x4 bv[2][2];
#pragma unroll
        for (int bj = 0; bj < 2; ++bj)
#pragma unroll
            for (int n = 0; n < 2; ++n) bv[bj][n] = bias ? *(const f32x4*)(bias + bcol0 + bj * HALF + 4 * n) : (f32x4){0.f, 0.f, 0.f, 0.f};
#pragma unroll
        for (int ai = 0; ai < 2; ++ai)
#pragma unroll
            for (int m = 0; m < 4; ++m) { bf16_t* rowp = base + (size_t)(row0 + ai * HALF + m * 16) * ldc + col0;
#pragma unroll
                for (int bj = 0; bj < 2; ++bj) { f32x4 v0 = acc[ai][bj][m][0] + bv[bj][0], v1 = acc[ai][bj][m][1] + bv[bj][1];
                    if (ACT == 1) { f32x2 a = gelu_pk((f32x2){v0[0], v0[1]}), b = gelu_pk((f32x2){v0[2], v0[3]}), c = gelu_pk((f32x2){v1[0], v1[1]}), d = gelu_pk((f32x2){v1[2], v1[3]});
                        v0 = (f32x4){a.x, a.y, b.x, b.y}; v1 = (f32x4){c.x, c.y, d.x, d.y}; }
                    v0 = v0 * sc; v1 = v1 * sc; u32x4 w; w.x = cvt_pk_bf16(v0[0], v0[1]); w.y = cvt_pk_bf16(v0[2], v0[3]); w.z = cvt_pk_bf16(v1[0], v1[1]); w.w = cvt_pk_bf16(v1[2], v1[3]);
                    *(u32x4*)(rowp + bj * HALF) = w; } }
    }
};

template <class Epi, class Sched, bool ALIGN_EPI = false, bool SP2 = false>
__device__ __forceinline__ void gemm_phase(PG8_LAS unsigned char* lds, const Gemm g, const Sched& S, const Epi& E) {
    int tid_l = threadIdx.x; asm volatile("" : "+v"(tid_l));
    const int tid = tid_l, wid = __builtin_amdgcn_readfirstlane(tid >> 6), lane = tid & 63, wr = wid >> 2, wc = wid & 3, fr = lane & 15, fq = lane >> 4;
    const int K = g.K, nt = K / BK;
    unsigned voffA[2], voffB[2];
#pragma unroll
    for (int i = 0; i < 2; ++i) { int R, C; stage_rc(tid * 16 + i * 8192, R, C); const int Rb = Epi::PERM ? ((R & ~31) + perm32(R & 31)) : R;
        voffA[i] = (unsigned)(R * K + C) * 2u; voffB[i] = (unsigned)(Rb * K + C) * 2u; }
    const size_t kstep = (size_t)(BK * 2);
    const size_t hstep = (size_t)HALF * K * 2;
    const size_t tstep = 2 * hstep;
    const unsigned ldsw = (unsigned)wid * 1024u;
    const int aoff = lds_byte(wr * 64 + fr, fq * 8), boff = lds_byte(wc * 32 + fr, fq * 8);
#define PG8_SA(b, h) (((b) * 2 + (h)) * HTB)
#define PG8_SB(b, h) ((4 + (b) * 2 + (h)) * HTB)
#define PG8_STAGE(bufoff, gbase, voff) do { _Pragma("unroll") for (int _i = 0; _i < 2; ++_i) \
        __builtin_amdgcn_global_load_lds((const unsigned*)((const char*)(gbase) + (voff)[_i]), (PG8_LAS unsigned*)(lds + (bufoff) + ldsw + _i * 8192), 16, 0, 0); } while (0)
#define PG8_LDA(dst, b, h) do { _Pragma("unroll") for (int m = 0; m < 4; ++m) _Pragma("unroll") for (int k = 0; k < 2; ++k) dst[m][k] = *(const PG8_LAS bf16x8*)(lds + PG8_SA(b, h) + aoff + m * 2048 + k * 1024); } while (0)
#define PG8_LDB(dst, b, h) do { _Pragma("unroll") for (int n = 0; n < 2; ++n) _Pragma("unroll") for (int k = 0; k < 2; ++k) dst[n][k] = *(const PG8_LAS bf16x8*)(lds + PG8_SB(b, h) + boff + n * 2048 + k * 1024); } while (0)
#define PG8_MMA(ai, bj, At, Bt) do { __builtin_amdgcn_s_setprio(1); _Pragma("unroll") for (int m = 0; m < 4; ++m) _Pragma("unroll") for (int n = 0; n < 2; ++n) _Pragma("unroll") for (int k = 0; k < 2; ++k) \
        acc[ai][bj][m][n] = __builtin_amdgcn_mfma_f32_16x16x32_bf16(Bt[n][k], At[m][k], acc[ai][bj][m][n], 0, 0, 0); __builtin_amdgcn_s_setprio(0); } while (0)
#define PG8_WAIT_V(n) asm volatile("s_waitcnt vmcnt(" #n ")" ::: "memory")
#define PG8_WAIT_L(n) asm volatile("s_waitcnt lgkmcnt(" #n ")" ::: "memory")
#define PG8_BAR __builtin_amdgcn_s_barrier()
#define PG8_SCHED __builtin_amdgcn_sched_barrier(0)
    Unit cur, nxt; int ui = 0;
    if (!S.next(0, cur)) return;
    f32x4 acc[2][2][4][2];
#pragma unroll
    for (int a = 0; a < 2; ++a)
#pragma unroll
        for (int b = 0; b < 2; ++b)
#pragma unroll
            for (int m = 0; m < 4; ++m)
#pragma unroll
                for (int n = 0; n < 2; ++n) acc[a][b][m][n] = (f32x4){0.f, 0.f, 0.f, 0.f};
    bf16x8 At[4][2], B0[2][2], B1[2][2];
    const char* cA = (const char*)g.A + (size_t)cur.pm * tstep; const char* cB = (const char*)g.Bt + (size_t)cur.pn * tstep;
    S.a_ready(cur, 0);
    if constexpr (SP2) {
        PG8_STAGE(PG8_SB(0, 0), cB, voffB); PG8_STAGE(PG8_SB(0, 1), cB + hstep, voffB); PG8_STAGE(PG8_SA(0, 0), cA, voffA); PG8_STAGE(PG8_SA(0, 1), cA + hstep, voffA);
        if (wr == 1) PG8_BAR;
        PG8_WAIT_V(2); PG8_BAR;
        PG8_STAGE(PG8_SB(1, 0), cB + kstep, voffB); PG8_STAGE(PG8_SA(1, 0), cA + kstep, voffA); PG8_STAGE(PG8_SB(1, 1), cB + hstep + kstep, voffB);
        PG8_WAIT_V(6); PG8_BAR;
    } else {
        PG8_STAGE(PG8_SB(0, 0), cB, voffB); PG8_STAGE(PG8_SA(0, 0), cA, voffA); PG8_STAGE(PG8_SB(0, 1), cB + hstep, voffB); PG8_STAGE(PG8_SA(0, 1), cA + hstep, voffA);
        if (wr == 1) PG8_BAR;
        PG8_WAIT_V(4); PG8_BAR;
        PG8_STAGE(PG8_SB(1, 0), cB + kstep, voffB); PG8_STAGE(PG8_SA(1, 0), cA + kstep, voffA); PG8_STAGE(PG8_SB(1, 1), cB + hstep + kstep, voffB);
        PG8_WAIT_V(6); PG8_BAR;
    }
    for (;;) {
        const bool has_next = S.next(ui + 1, nxt);
        const char* nA = has_next ? (const char*)g.A + (size_t)nxt.pm * tstep : cA; const char* nB = has_next ? (const char*)g.Bt + (size_t)nxt.pn * tstep : cB;
        for (int t = 0; t < nt; t += 2) {
            const bool last = (t == nt - 2);
            const char* a1 = cA + (size_t)(t + 1) * kstep;
            const char* a2 = last ? nA : cA + (size_t)(t + 2) * kstep; const char* b2 = last ? nB : cB + (size_t)(t + 2) * kstep;
            const char* a3 = a2 + kstep; const char* b3 = b2 + kstep;
            if (last && has_next) S.a_ready(nxt, ui + 1);
            if constexpr (SP2) {
            PG8_LDB(B0, 0, 0); PG8_LDB(B1, 0, 1); PG8_SCHED; PG8_LDA(At, 0, 0); PG8_STAGE(PG8_SA(1, 1), a1 + hstep, voffA);
            PG8_WAIT_V(8); PG8_WAIT_L(0); PG8_BAR; PG8_MMA(0, 0, At, B0); PG8_MMA(0, 1, At, B1); PG8_BAR; PG8_SCHED;
            PG8_LDA(At, 0, 1); PG8_STAGE(PG8_SB(0, 0), b2, voffB); PG8_STAGE(PG8_SB(0, 1), b2 + hstep, voffB); PG8_STAGE(PG8_SA(0, 0), a2, voffA);
            PG8_WAIT_V(8); PG8_WAIT_L(0); PG8_BAR; PG8_MMA(1, 0, At, B0); PG8_MMA(1, 1, At, B1); PG8_BAR; PG8_SCHED;
            PG8_LDB(B0, 1, 0); PG8_LDB(B1, 1, 1); PG8_SCHED; PG8_LDA(At, 1, 0); PG8_STAGE(PG8_SA(0, 1), a2 + hstep, voffA);
            PG8_WAIT_V(8); PG8_WAIT_L(0); PG8_BAR; PG8_MMA(0, 0, At, B0); PG8_MMA(0, 1, At, B1); PG8_BAR; PG8_SCHED;
            PG8_LDA(At, 1, 1); PG8_STAGE(PG8_SB(1, 0), b3, voffB); PG8_STAGE(PG8_SB(1, 1), b3 + hstep, voffB); PG8_STAGE(PG8_SA(1, 0), a3, voffA);
            PG8_WAIT_V(8); PG8_WAIT_L(0); PG8_BAR; PG8_MMA(1, 0, At, B0); PG8_MMA(1, 1, At, B1); PG8_BAR; PG8_SCHED;
            } else {
            PG8_LDB(B0, 0, 0); PG8_SCHED; PG8_LDA(At, 0, 0); PG8_STAGE(PG8_SA(1, 1), a1 + hstep, voffA);
            PG8_WAIT_L(8); PG8_BAR; PG8_WAIT_L(0); PG8_MMA(0, 0, At, B0); PG8_BAR; PG8_SCHED;
            PG8_LDB(B1, 0, 1); PG8_STAGE(PG8_SB(0, 0), b2, voffB);
            PG8_BAR; PG8_WAIT_L(0); PG8_MMA(0, 1, At, B1); PG8_BAR;
            PG8_LDA(At, 0, 1); PG8_STAGE(PG8_SA(0, 0), a2, voffA);
            PG8_BAR; PG8_WAIT_L(0); PG8_MMA(1, 0, At, B0); PG8_BAR; PG8_SCHED;
            PG8_STAGE(PG8_SB(0, 1), b2 + hstep, voffB);
            PG8_WAIT_V(6); PG8_BAR; PG8_MMA(1, 1, At, B1); PG8_BAR;
            PG8_LDB(B0, 1, 0); PG8_SCHED; PG8_LDA(At, 1, 0); PG8_STAGE(PG8_SA(0, 1), a2 + hstep, voffA);
            PG8_WAIT_L(8); PG8_BAR; PG8_WAIT_L(0); PG8_MMA(0, 0, At, B0); PG8_BAR; PG8_SCHED;
            PG8_LDB(B1, 1, 1); PG8_STAGE(PG8_SB(1, 0), b3, voffB);
            PG8_BAR; PG8_WAIT_L(0); PG8_MMA(0, 1, At, B1); PG8_BAR;
            PG8_LDA(At, 1, 1); PG8_STAGE(PG8_SA(1, 0), a3, voffA);
            PG8_BAR; PG8_WAIT_L(0); PG8_MMA(1, 0, At, B0); PG8_BAR; PG8_SCHED;
            PG8_STAGE(PG8_SB(1, 1), b3 + hstep, voffB);
            PG8_WAIT_V(6); PG8_BAR; PG8_MMA(1, 1, At, B1); PG8_BAR;
            }
        }
        if constexpr (ALIGN_EPI) { if (wr == 0) PG8_BAR; }
        if constexpr (!Epi::AFTER_DRAIN) { E(acc, cur, wr, wc, fr, fq); S.done(cur); }
        if (!has_next) break;
#pragma unroll
        for (int a = 0; a < 2; ++a)
#pragma unroll
            for (int b = 0; b < 2; ++b)
#pragma unroll
                for (int m = 0; m < 4; ++m)
#pragma unroll
                    for (int n = 0; n < 2; ++n) acc[a][b][m][n] = (f32x4){0.f, 0.f, 0.f, 0.f};
        cur = nxt; cA = nA; cB = nB; ++ui;
        if constexpr (ALIGN_EPI) { if (wr == 1) PG8_BAR; }
    }
    PG8_WAIT_V(0);
    if constexpr (!ALIGN_EPI) { if (wr == 0) PG8_BAR; }
    PG8_BAR;
    if constexpr (Epi::AFTER_DRAIN) { E.fused(acc, cur, wr, wc, fr, fq, lds, wid, lane); S.done(cur); }
#undef PG8_SA
#undef PG8_SB
#undef PG8_STAGE
#undef PG8_LDA
#undef PG8_LDB
#undef PG8_MMA
#undef PG8_WAIT_V
#undef PG8_WAIT_L
#undef PG8_BAR
#undef PG8_SCHED
}
}
namespace pg8 {
typedef unsigned u32x2 __attribute__((ext_vector_type(2)));
__device__ __forceinline__ float sigmoid_f(float v) { return __builtin_amdgcn_rcpf(1.0f + __builtin_amdgcn_exp2f(-1.4426950408889634f * v)); }
__device__ __forceinline__ float silu_f(float v) { return v * sigmoid_f(v); }
__device__ __forceinline__ float logsigmoid_f(float v) { return fminf(v, 0.f) - log1pf(__expf(-fabsf(v))); }
struct EpiSwiglu {
    static constexpr bool PERM = true, AFTER_DRAIN = false;
    bf16_t* H; int ldh;
    __device__ __forceinline__ void operator()(const f32x4 (&acc)[2][2][4][2], const Unit& u, int wr, int wc, int fr, int fq) const {
        const int row0 = u.pm * BM + wr * 64 + fr, col0 = u.pn * HALF + wc * 32 + 8 * fq;
#pragma unroll
        for (int ai = 0; ai < 2; ++ai)
#pragma unroll
            for (int m = 0; m < 4; ++m) { bf16_t* rowp = H + (size_t)(row0 + ai * HALF + m * 16) * ldh + col0;
                const f32x4 g0 = acc[ai][0][m][0], g1 = acc[ai][0][m][1], u0 = acc[ai][1][m][0], u1 = acc[ai][1][m][1];
                u32x4 w; w.x = cvt_pk_bf16(silu_f(g0[0]) * u0[0], silu_f(g0[1]) * u0[1]); w.y = cvt_pk_bf16(silu_f(g0[2]) * u0[2], silu_f(g0[3]) * u0[3]);
                w.z = cvt_pk_bf16(silu_f(g1[0]) * u1[0], silu_f(g1[1]) * u1[1]); w.w = cvt_pk_bf16(silu_f(g1[2]) * u1[2], silu_f(g1[3]) * u1[3]);
                *(u32x4*)rowp = w; }
    }
};
struct EpiResid {
    static constexpr bool PERM = true, AFTER_DRAIN = false;
    const float* xin32; const bf16_t* xin16; bf16_t* out; const float* gate; float alpha, gs; int rows_per_batch, gate_stride; const float* stats; const float* lng; const float* lnb;
    __device__ __forceinline__ void operator()(const f32x4 (&acc)[2][2][4][2], const Unit& u, int wr, int wc, int fr, int fq) const {
        const int b = (u.pm * BM) / rows_per_batch; const float* gp = gate + (size_t)b * gate_stride;
        const int col0 = u.pn * BM + wc * 32 + 8 * fq, row0 = u.pm * BM + wr * 64 + fr;
        f32x4 gv[2][2], lg[2][2], lb[2][2];
#pragma unroll
        for (int bj = 0; bj < 2; ++bj)
#pragma unroll
            for (int n = 0; n < 2; ++n) { const int c = col0 + bj * HALF + n * 4; gv[bj][n] = (*(const f32x4*)(gp + c) + 1.0f) * gs;
                if (stats) { lg[bj][n] = *(const f32x4*)(lng + c); lb[bj][n] = *(const f32x4*)(lnb + c); } }
        f32x4 xb[8][2][2]; float mean[8], rstd[8];
#define RES_LOAD(r_) do { const int row_ = row0 + ((r_) >> 2) * HALF + ((r_) & 3) * 16; \
            if (stats) { mean[r_] = stats[2 * row_]; rstd[r_] = stats[2 * row_ + 1]; } else { mean[r_] = 0.f; rstd[r_] = 1.f; } \
            _Pragma("unroll") for (int bj = 0; bj < 2; ++bj) { \
                if (xin16) { const u32x4 w_ = *(const u32x4*)(xin16 + (size_t)row_ * 2048 + col0 + bj * HALF); \
                    xb[r_][bj][0] = (f32x4){__uint_as_float(w_.x << 16), __uint_as_float(w_.x & 0xffff0000u), __uint_as_float(w_.y << 16), __uint_as_float(w_.y & 0xffff0000u)}; \
                    xb[r_][bj][1] = (f32x4){__uint_as_float(w_.z << 16), __uint_as_float(w_.z & 0xffff0000u), __uint_as_float(w_.w << 16), __uint_as_float(w_.w & 0xffff0000u)}; } \
                else { xb[r_][bj][0] = *(const f32x4*)(xin32 + (size_t)row_ * 2048 + col0 + bj * HALF); xb[r_][bj][1] = *(const f32x4*)(xin32 + (size_t)row_ * 2048 + col0 + bj * HALF + 4); } } } while (0)
        RES_LOAD(0);
#pragma unroll
        for (int r = 0; r < 8; ++r) {
            if (r + 1 < 8) RES_LOAD(r + 1);
            asm volatile("" ::: "memory");
            const int row = row0 + (r >> 2) * HALF + (r & 3) * 16;
#pragma unroll
            for (int bj = 0; bj < 2; ++bj) { f32x4 o[2];
#pragma unroll
                for (int n = 0; n < 2; ++n) { f32x4 xv = xb[r][bj][n];
                    if (stats) xv = (xv - mean[r]) * rstd[r] * lg[bj][n] + lb[bj][n];
                    o[n] = xv * alpha + gv[bj][n] * acc[r >> 2][bj][r & 3][n]; }
                u32x4 w; w.x = cvt_pk_bf16(o[0][0], o[0][1]); w.y = cvt_pk_bf16(o[0][2], o[0][3]); w.z = cvt_pk_bf16(o[1][0], o[1][1]); w.w = cvt_pk_bf16(o[1][2], o[1][3]);
                *(u32x4*)(out + (size_t)row * 2048 + col0 + bj * HALF) = w; }
            asm volatile("" ::: "memory");
        }
#undef RES_LOAD
    }
};
struct EpiInproj {
    static constexpr bool PERM = true, AFTER_DRAIN = false;
    bf16_t* Z; float* gates; const float* fox_fb; const float* ml_ib; const float* ml_fb;
    __device__ __forceinline__ void operator()(const f32x4 (&acc)[2][2][4][2], const Unit& u, int wr, int wc, int fr, int fq) const {
        const int row0 = u.pm * BM + wr * 64 + fr;
        if (u.pn < 24) {
            const int col0 = u.pn * BM + wc * 32 + 8 * fq; const bool sg = u.pn >= 20;
#pragma unroll
            for (int ai = 0; ai < 2; ++ai)
#pragma unroll
                for (int m = 0; m < 4; ++m) { bf16_t* rowp = Z + (size_t)(row0 + ai * HALF + m * 16) * 6144 + col0;
#pragma unroll
                    for (int bj = 0; bj < 2; ++bj) { f32x4 v0 = acc[ai][bj][m][0], v1 = acc[ai][bj][m][1];
                        if (sg) { v0 = (f32x4){sigmoid_f(v0[0]), sigmoid_f(v0[1]), sigmoid_f(v0[2]), sigmoid_f(v0[3])}; v1 = (f32x4){sigmoid_f(v1[0]), sigmoid_f(v1[1]), sigmoid_f(v1[2]), sigmoid_f(v1[3])}; }
                        u32x4 w; w.x = cvt_pk_bf16(v0[0], v0[1]); w.y = cvt_pk_bf16(v0[2], v0[3]); w.z = cvt_pk_bf16(v1[0], v1[1]); w.w = cvt_pk_bf16(v1[2], v1[3]);
                        *(u32x4*)(rowp + bj * HALF) = w; } }
        } else if (wc == 0 && fq < 2) {
#pragma unroll
            for (int ai = 0; ai < 2; ++ai)
#pragma unroll
                for (int m = 0; m < 4; ++m) { float* gp = gates + (size_t)(row0 + ai * HALF + m * 16) * 16 + 8 * fq;
#pragma unroll
                    for (int n = 0; n < 2; ++n) { const f32x4 v = acc[ai][0][m][n]; f32x4 o;
                        if (fq == 0) { const f32x4 bb = *(const f32x4*)(fox_fb + 4 * n); o = (f32x4){logsigmoid_f(v[0] + bb[0]), logsigmoid_f(v[1] + bb[1]), logsigmoid_f(v[2] + bb[2]), logsigmoid_f(v[3] + bb[3])}; }
                        else if (n == 0) { const f32x4 bb = *(const f32x4*)ml_ib; o = v + bb; }
                        else { const f32x4 bb = *(const f32x4*)ml_fb; o = (f32x4){logsigmoid_f(v[0] + bb[0]), logsigmoid_f(v[1] + bb[1]), logsigmoid_f(v[2] + bb[2]), logsigmoid_f(v[3] + bb[3])}; }
                        *(f32x4*)(gp + 4 * n) = o; } }
        }
    }
};
struct AlignedOrder : StaticOrder {
    unsigned* cnt; int full_rounds;
    __device__ __forceinline__ void a_ready(const Unit&, int i) const {
        if (i > 0 && i < full_rounds) {
            if (threadIdx.x < 64) {
                unsigned* w = cnt + 64 * (c & 7);
                if (threadIdx.x == 0) (void)__hip_atomic_fetch_add(w, 1u, __ATOMIC_RELAXED, __HIP_MEMORY_SCOPE_AGENT);
                const unsigned need = (unsigned)i * (unsigned)(G >> 3); const unsigned long long t0 = __builtin_amdgcn_s_memrealtime();
                while ((unsigned)__builtin_amdgcn_readfirstlane(__hip_atomic_load(w, __ATOMIC_RELAXED, __HIP_MEMORY_SCOPE_AGENT)) < need) {
                    if (__builtin_amdgcn_s_memrealtime() - t0 > 1500ull) break;
                    __builtin_amdgcn_s_sleep(1); }
            }
            asm volatile("" ::: "memory"); __builtin_amdgcn_s_barrier(); asm volatile("" ::: "memory");
        }
    }
};
}
#define LAS __attribute__((address_space(3)))
#define XB_TMO      128
#define XB_XCNT(j)  (256  + 64 * (j))
#define XB_XSUB(j)  (1280 + 64 * (j))
#define XB_XGEN(j)  (2304 + 64 * (j))
#define XB_TOP      3328
#define XB_TOPGEN   3392
#define XCD_BAR_WORDS 3456
#define XB_SPIN_CAP (1u << 18)

__device__ __forceinline__ unsigned xb_ld(unsigned* p)              { return __hip_atomic_load(p, __ATOMIC_RELAXED, __HIP_MEMORY_SCOPE_AGENT); }
__device__ __forceinline__ unsigned xb_add(unsigned* p, unsigned v) { return __hip_atomic_fetch_add(p, v, __ATOMIC_RELAXED, __HIP_MEMORY_SCOPE_AGENT); }
__device__ __forceinline__ unsigned xb_xcc_id() { return (unsigned)__builtin_amdgcn_s_getreg((3 << 11) | 20) & 0xFu; }
#define XB_SPIN(cond, bar) do { unsigned _sp = 0; while (cond) { __builtin_amdgcn_s_sleep(1); \
    if ((++_sp & 255u) == 0u) { if (xb_ld(&(bar)[XB_TMO])) break; if (_sp > XB_SPIN_CAP) { atomicAdd(&(bar)[XB_TMO], 1u); break; } } } } while (0)

struct XcdBarrier {
    unsigned* bar; unsigned x;
    volatile LAS unsigned* st;
};

__device__ __forceinline__ XcdBarrier xcd_barrier_post(unsigned* bar, volatile LAS unsigned* st) {
    XcdBarrier b; b.bar = bar; b.x = xb_xcc_id(); b.st = st;
    if (threadIdx.x == 0) (void)xb_add(&bar[XB_XCNT(b.x)], 1u);
    return b;
}
__device__ __forceinline__ void xcd_barrier_complete(unsigned* bar, unsigned x, unsigned& nloc, unsigned& nx) {
    const unsigned G = gridDim.x * gridDim.y * gridDim.z;
    unsigned sum, cnt, mine, sp = 0u;
    for (;;) {
        sum = 0u; cnt = 0u; mine = 0u;
#pragma unroll
        for (unsigned j = 0; j < 16; ++j) { const unsigned c = xb_ld(&bar[XB_XCNT(j)]); sum += c; cnt += (c > 0u) ? 1u : 0u; mine = (j == x) ? c : mine; }
        if (sum == G) break;
        __builtin_amdgcn_s_sleep(1);
        if ((++sp & 255u) == 0u) { if (xb_ld(&bar[XB_TMO])) break; if (sp > XB_SPIN_CAP) { atomicAdd(&bar[XB_TMO], 1u); break; } }
    }
    nloc = mine > 0u ? mine : 1u; nx = cnt > 0u ? cnt : 1u;
}

__device__ __forceinline__ void xcd_barrier(const XcdBarrier& b) {
    asm volatile("s_waitcnt vmcnt(0)" ::: "memory");
    __syncthreads();
    if (threadIdx.x == 0) {
        unsigned* bar = b.bar;
        __builtin_amdgcn_s_waitcnt(0);
        unsigned nloc = b.st[0], nx = b.st[1];
        if (nloc == 0u) { xcd_barrier_complete(bar, b.x, nloc, nx); b.st[0] = nloc; b.st[1] = nx; }
        const unsigned old = xb_add(&bar[XB_XSUB(b.x)], 1u);
        const unsigned gen = old / nloc;
        if (old + 1u == (gen + 1u) * nloc) {
            __builtin_amdgcn_fence(__ATOMIC_RELEASE, "agent");
            asm volatile("s_waitcnt vmcnt(0)" ::: "memory");
            const unsigned og = xb_add(&bar[XB_TOP], 1u);
            const unsigned tg = og / nx;
            if (og + 1u == (tg + 1u) * nx) xb_add(&bar[XB_TOPGEN], 1u);
            else XB_SPIN(xb_ld(&bar[XB_TOPGEN]) == tg, bar);
            __builtin_amdgcn_fence(__ATOMIC_ACQUIRE, "agent");
            xb_add(&bar[XB_XGEN(b.x)], 1u);
            asm volatile("s_waitcnt vmcnt(0)" ::: "memory");
        } else {
            XB_SPIN(xb_ld(&bar[XB_XGEN(b.x)]) == gen, bar);
            __builtin_amdgcn_fence(__ATOMIC_ACQUIRE, "agent");
            asm volatile("s_waitcnt vmcnt(0)" ::: "memory");
        }
    }
    __syncthreads();
}

namespace mk {
using pg8::bf16_t; using pg8::bf16x8; using pg8::f32x4; using pg8::u32x4; using pg8::u32x2;
constexpr int NT = 512, NWV = 8;
constexpr int T = 32768, SEQ = 16384, DM = 2048, DFF = 5632, NINP = 6400, ZP = 6144, NADA = 18432, INW = 6160;
constexpr float ALPHA = 1.189207115002721f, LN_EPS = 1e-5f, SQRT_DH = 11.313708498984761f, RSQRT_DK = 0.08838834764831845f;
constexpr size_t MiB = 1u << 20;
constexpr size_t WS_BAR = 512 * 1024  , WS_CTRL = 256 * 1024  , WS_ADA = 0, WS_GATES = 1 * MiB, WS_FS = 3 * MiB, WS_BCS = 4 * MiB, WS_SCAL = 4 * MiB + 768 * 1024, WS_NST = 5 * MiB, WS_STATS = 6 * MiB  , WS_R = 880 * MiB  ;
constexpr size_t WS_W1T = 8 * MiB, WS_W1O = 52 * MiB, WS_WIN = 74 * MiB, WS_WOT = 99 * MiB, WS_W2T = 107 * MiB, WS_W2O = 151 * MiB;
constexpr size_t WS_A = 176 * MiB, WS_Z = 304 * MiB, WS_QKC = 688 * MiB, WS_CST = 752 * MiB, WS_END = 1008 * MiB;
constexpr int LDS_BYTES = 147456;

struct Params {
    const float *x, *c, *w_ada, *b_ada, *f1_in, *f1_out, *ln1_g, *ln1_b, *w_in, *fox_fb, *conv_w, *conv_b, *ml_ib, *ml_fb, *ml_ng, *w_out, *ln2_g, *ln2_b, *f2_in, *f2_out, *ln3_g, *ln3_b;
    float* out; unsigned char* ws;
};
__device__ __forceinline__ unsigned pk2(float a, float b) { return pg8::cvt_pk_bf16(a, b); }
__device__ __forceinline__ float bf2f(unsigned short h) { return __uint_as_float((unsigned)h << 16); }
__device__ __forceinline__ int tsw(int row, int col) { return row * 72 + (col ^ (((row >> 3) & 7) << 3)); }
template <int CTRL> __device__ __forceinline__ float dpp_f(float v) { return __builtin_bit_cast(float, __builtin_amdgcn_update_dpp(0, __builtin_bit_cast(int, v), CTRL, 0xF, 0xF, true)); }
__device__ __forceinline__ float quad_sum(float v) { v += dpp_f<0xB1>(v); v += dpp_f<0x4E>(v); return v; }
__device__ __forceinline__ float oct_sum(float v) { v = quad_sum(v); v += dpp_f<0x141>(v); return v; }
__device__ __forceinline__ float row16_sum(float v) { v = oct_sum(v); v += dpp_f<0x140>(v); return v; }
__device__ __forceinline__ float swap16_sum(float v) { auto r = __builtin_amdgcn_permlane16_swap(__float_as_uint(v), __float_as_uint(v), false, false); return __uint_as_float(r[0]) + __uint_as_float(r[1]); }
__device__ __forceinline__ float swap32_sum(float v) { auto r = __builtin_amdgcn_permlane32_swap(__float_as_uint(v), __float_as_uint(v), false, false); return __uint_as_float(r[0]) + __uint_as_float(r[1]); }
__device__ __forceinline__ float wave_sum(float v) { return swap32_sum(swap16_sum(row16_sum(v))); }
#define LDS_WAIT() asm volatile("s_waitcnt lgkmcnt(0)" ::: "memory")
#define LDS_BARRIER() do { asm volatile("s_waitcnt lgkmcnt(0)" ::: "memory"); __builtin_amdgcn_s_barrier(); asm volatile("" ::: "memory"); } while (0)

struct TrItem { const float* src; bf16_t* dst; int N, K; };
__device__ __forceinline__ TrItem tr_make(const float* W, int N, int K, bf16_t* WT, int src_col, int dst_row, int k0, int lane) {
    const int kb = lane >> 3, nq = lane & 7; TrItem t; t.N = N; t.K = K;
    t.src = W + (size_t)(k0 + 8 * kb) * N + src_col + 4 * nq; t.dst = WT + (size_t)(dst_row + 4 * nq) * K + k0 + 8 * kb; return t;
}
__device__ __forceinline__ void tr_load(const TrItem& t, f32x4 (&r)[8]) {
#pragma unroll
    for (int jj = 0; jj < 8; ++jj) r[jj] = *(const f32x4*)(t.src + (size_t)jj * t.N);
}
__device__ __forceinline__ void tr_store(const TrItem& t, const f32x4 (&r)[8]) {
#pragma unroll
    for (int i = 0; i < 4; ++i) { u32x4 o; o.x = pk2(r[0][i], r[1][i]); o.y = pk2(r[2][i], r[3][i]); o.z = pk2(r[4][i], r[5][i]); o.w = pk2(r[6][i], r[7][i]);
        *(u32x4*)(t.dst + (size_t)i * t.K) = o; }
}
__device__ __forceinline__ void p0_prologue(const Params& p, LAS unsigned char* lds) {
    int tid_l = threadIdx.x; asm volatile("" : "+v"(tid_l)); const int tid = tid_l, lane = tid & 63, wave = tid >> 6;
    unsigned char* ws = p.ws;
    float* ada = (float*)(ws + WS_ADA);
    if (blockIdx.x == 0 && tid < 64) ((unsigned*)(ws + WS_CTRL))[tid] = (tid >= 48) ? 0xFFFFFFFFu : 0u;
    if (blockIdx.x < NADA / 128) {
        LAS float* sc = (LAS float*)lds;
        LAS float* red = (LAS float*)(lds + 16384);
        for (int i = tid; i < 2 * DM; i += NT) { const float v = p.c[i]; sc[i] = pg8::silu_f(v); }
        __syncthreads();
        const int cl = tid & 31, kg = tid >> 5, col = blockIdx.x * 128 + 4 * cl;
        f32x4 a0 = {0.f, 0.f, 0.f, 0.f}, a1 = {0.f, 0.f, 0.f, 0.f};
#pragma unroll 16
        for (int kk = 0; kk < 128; ++kk) { const int k = kg * 128 + kk; const f32x4 w = *(const f32x4*)(p.w_ada + (size_t)k * NADA + col);
            a0 += w * sc[k]; a1 += w * sc[DM + k]; }
        *(LAS f32x4*)(red + (kg * 2 + 0) * 128 + 4 * cl) = a0; *(LAS f32x4*)(red + (kg * 2 + 1) * 128 + 4 * cl) = a1;
        __syncthreads();
        if (tid < 256) { const int b = tid >> 7, cc = tid & 127; float s = p.b_ada[blockIdx.x * 128 + cc];
#pragma unroll
            for (int g = 0; g < 16; ++g) s += red[(g * 2 + b) * 128 + cc];
            ada[b * NADA + blockIdx.x * 128 + cc] = s; }
        __syncthreads();
    }
    constexpr int I_F1I = 32 * 352, I_F1O = 88 * 64, I_WIN = 32 * 192, I_WOT = 32 * 64;
    constexpr int NITEMS = 2 * (I_F1I + I_F1O) + I_WIN + I_WOT;
    bf16_t* W1T = (bf16_t*)(ws + WS_W1T); bf16_t* W1O = (bf16_t*)(ws + WS_W1O); bf16_t* WIN = (bf16_t*)(ws + WS_WIN); bf16_t* WOT = (bf16_t*)(ws + WS_WOT);
    bf16_t* W2T = (bf16_t*)(ws + WS_W2T); bf16_t* W2O = (bf16_t*)(ws + WS_W2O);
    const int gw = blockIdx.x * NWV + wave, NGW = gridDim.x * NWV;
    auto decode = [&](int it) -> TrItem {
        int r = it;
        if (r < 2 * I_F1I) {
            const bool second = r >= I_F1I; if (second) r -= I_F1I;
            const int kb = r / 352, db = r % 352, pn = db >> 3, wi = db & 7;
            const int src = (wi < 4) ? (128 * pn + 32 * wi) : (DFF + 128 * pn + 32 * (wi - 4));
            return tr_make(second ? p.f2_in : p.f1_in, 2 * DFF, DM, second ? W2T : W1T, src, 32 * db, 64 * kb, lane); }
        r -= 2 * I_F1I;
        if (r < 2 * I_F1O) { const bool second = r >= I_F1O; if (second) r -= I_F1O;
            const int kb = r / 64, db = r % 64;
            return tr_make(second ? p.f2_out : p.f1_out, DM, DFF, second ? W2O : W1O, 32 * db, 32 * db, 64 * kb, lane); }
        r -= 2 * I_F1O;
        if (r < I_WIN) { const int kb = r / 192, db = r % 192, dst = 32 * db;
            const int src = dst < 3072 ? dst : (dst < 4096 ? 3080 + (dst - 3072) : (dst < 5120 ? 4104 + (dst - 4096) : 5136 + (dst - 5120)));
            return tr_make(p.w_in, INW, DM, WIN, src, dst, 64 * kb, lane); }
        r -= I_WIN;
        const int kb = r / 64, db = r % 64; return tr_make(p.w_out, DM, DM, WOT, 32 * db, 32 * db, 64 * kb, lane); };
    if (gw < NITEMS) {
        int it = gw; TrItem cur = decode(it); f32x4 rc[8]; tr_load(cur, rc);
        for (;;) { const int nit = it + NGW; const bool has = nit < NITEMS; TrItem nx = cur; f32x4 rn[8];
            if (has) { nx = decode(nit); tr_load(nx, rn); }
            asm volatile("" ::: "memory");
            tr_store(cur, rc);
            if (!has) break;
            cur = nx; it = nit;
#pragma unroll
            for (int jj = 0; jj < 8; ++jj) rc[jj] = rn[jj]; }
    }
    for (int idx0 = blockIdx.x * NT + tid; idx0 < 256 * DM; idx0 += 4 * gridDim.x * NT) { float v[4];
#pragma unroll
        for (int i = 0; i < 4; ++i) { const int idx = idx0 + i * gridDim.x * NT, r = idx >> 11, k = idx & (DM - 1);
            const int src = r < 8 ? 3072 + r : (r < 12 ? 5128 + (r - 8) : (r < 16 ? 5132 + (r - 12) : -1));
            v[i] = (idx < 256 * DM && src >= 0) ? p.w_in[(size_t)k * INW + src] : 0.f; }
#pragma unroll
        for (int i = 0; i < 4; ++i) { const int idx = idx0 + i * gridDim.x * NT, r = idx >> 11, k = idx & (DM - 1);
            if (idx < 256 * DM) WIN[(size_t)(6144 + r) * DM + k] = (bf16_t)(pk2(v[i], 0.f) & 0xffffu); } }
}

template <int MODE>
__device__ __forceinline__ void ln_phase(const void* in_, float* xout, bf16_t* aout, const float* g, const float* bb, const float* ada_shift, const float* ada_scale, float* stats_out) {
    int tid_l = threadIdx.x; asm volatile("" : "+v"(tid_l)); const int tid = tid_l, lane = tid & 63, wave = tid >> 6;
    const int gw = blockIdx.x * NWV + wave, NGW = gridDim.x * NWV;
    f32x4 gv[8], bv[8];
    if (MODE != 0) {
#pragma unroll
        for (int j = 0; j < 8; ++j) { gv[j] = *(const f32x4*)(g + 256 * j + 4 * lane); bv[j] = *(const f32x4*)(bb + 256 * j + 4 * lane); }
    }
    f32x4 vn[8];
#define LN_LOAD(row_) do { if (MODE == 0) { const f32x4* xr = (const f32x4*)((const float*)in_ + (size_t)(row_) * DM) + lane; _Pragma("unroll") for (int j = 0; j < 8; ++j) vn[j] = xr[64 * j]; } \
        else { const u32x2* xr = (const u32x2*)((const bf16_t*)in_ + (size_t)(row_) * DM) + lane; \
            _Pragma("unroll") for (int j = 0; j < 8; ++j) { const u32x2 w = xr[64 * j]; vn[j] = (f32x4){__uint_as_float(w.x << 16), __uint_as_float(w.x & 0xffff0000u), __uint_as_float(w.y << 16), __uint_as_float(w.y & 0xffff0000u)}; } } } while (0)
    if (gw < T) LN_LOAD(gw);
    for (int row = gw; row < T; row += NGW) {
        const int b = row >> 14;
        f32x4 v[8]; float s = 0.f;
#pragma unroll
        for (int j = 0; j < 8; ++j) v[j] = vn[j];
        if (row + NGW < T) LN_LOAD(row + NGW);
#pragma unroll
        for (int j = 0; j < 8; ++j) s += (v[j][0] + v[j][1]) + (v[j][2] + v[j][3]);
        float mean = wave_sum(s) * (1.f / DM); float s2 = 0.f;
#pragma unroll
        for (int j = 0; j < 8; ++j) { v[j] = v[j] - mean; s2 += (v[j][0] * v[j][0] + v[j][1] * v[j][1]) + (v[j][2] * v[j][2] + v[j][3] * v[j][3]); }
        float rstd = 1.0f / sqrtf(wave_sum(s2) * (1.f / DM) + LN_EPS);
        if (MODE != 0) {
            f32x4* xo = (f32x4*)(xout + (size_t)row * DM) + lane; s = 0.f;
            if (MODE == 1 && lane == 0) { stats_out[2 * row] = mean; stats_out[2 * row + 1] = rstd; }
#pragma unroll
            for (int j = 0; j < 8; ++j) { v[j] = v[j] * rstd * gv[j] + bv[j]; if (MODE == 2) xo[64 * j] = v[j]; s += (v[j][0] + v[j][1]) + (v[j][2] + v[j][3]); }
            if (MODE == 1) {
                mean = wave_sum(s) * (1.f / DM); s2 = 0.f;
#pragma unroll
                for (int j = 0; j < 8; ++j) { v[j] = v[j] - mean; s2 += (v[j][0] * v[j][0] + v[j][1] * v[j][1]) + (v[j][2] * v[j][2] + v[j][3] * v[j][3]); }
                rstd = 1.0f / sqrtf(wave_sum(s2) * (1.f / DM) + LN_EPS);
            }
        }
        if (MODE != 2) {
            const float* sh = ada_shift + (size_t)b * NADA; const float* sc = ada_scale + (size_t)b * NADA;
            u32x2* ao = (u32x2*)(aout + (size_t)row * DM) + lane;
#pragma unroll
            for (int j = 0; j < 8; ++j) { const f32x4 shv = *(const f32x4*)(sh + 256 * j + 4 * lane), scv = *(const f32x4*)(sc + 256 * j + 4 * lane);
                const f32x4 y = v[j] * rstd * (scv + 1.0f) + shv; u32x2 w; w.x = pk2(y[0], y[1]); w.y = pk2(y[2], y[3]); ao[64 * j] = w; }
        }
    }
#undef LN_LOAD
}
__device__ __forceinline__ void p6_scalars_conv(const Params& p, LAS unsigned char* lds) {
    int tid_l = threadIdx.x; asm volatile("" : "+v"(tid_l)); const int tid = tid_l, lane = tid & 63, wave = tid >> 6;
    unsigned char* ws = p.ws;
    const float* gates = (const float*)(ws + WS_GATES);
    float* Fs = (float*)(ws + WS_FS); float* bcs = (float*)(ws + WS_BCS); float* scal = (float*)(ws + WS_SCAL);
    for (int task = blockIdx.x; task < 24; task += gridDim.x) {
        if (task < 16) {
            const int b = task >> 3, h = task & 7; LAS float* wt = (LAS float*)lds;
            const float* gp = gates + ((size_t)b * SEQ + (size_t)tid * 32) * 16 + h;
            float v[32]; float run = 0.f;
#pragma unroll
            for (int i = 0; i < 32; ++i) { run += gp[i * 16]; v[i] = run; }
            float inc = run;
#pragma unroll
            for (int o = 1; o < 64; o <<= 1) { const float t = __shfl_up(inc, o); if (lane >= o) inc += t; }
            if (lane == 63) wt[wave] = inc;
            __syncthreads();
            float off = inc - run;
            for (int w = 0; w < wave; ++w) off += wt[w];
            float* fo = Fs + (size_t)task * SEQ + tid * 32;
#pragma unroll
            for (int i = 0; i < 32; ++i) fo[i] = (v[i] + off) * SQRT_DH;
            __syncthreads();
        } else {
            const int bh = task - 16, b = bh >> 2, h = bh & 3; LAS float* bLs = (LAS float*)lds; LAS float* mls = bLs + 256;
            if (tid < 256) { const float* gp = gates + ((size_t)b * SEQ + (size_t)tid * 64) * 16; float run = 0.f, mx = -INFINITY;
                float* bo = bcs + (size_t)bh * SEQ + tid * 64;
#pragma unroll
                for (int s0 = 0; s0 < 64; s0 += 32) { float lf[32], gi[32];
#pragma unroll
                    for (int s = 0; s < 32; ++s) { lf[s] = gp[(s0 + s) * 16 + 12 + h]; gi[s] = gp[(s0 + s) * 16 + 8 + h]; }
#pragma unroll
                    for (int s = 0; s < 32; ++s) { run += lf[s]; bo[s0 + s] = run; mx = fmaxf(mx, gi[s] - run); } }
                bLs[tid] = run; mls[tid] = run + mx; }
            __syncthreads();
            if (tid == 0) { float m = 0.f;
                for (int k = 0; k < 256; ++k) { const float bl = bLs[k], mn = fmaxf(bl + m, mls[k]); float* so = scal + (size_t)(bh * 256 + k) * 4;
                    so[0] = m; so[1] = mn; so[2] = __expf(bl + m - mn); so[3] = 0.f; m = mn; } }
            __syncthreads();
        }
    }
    const bool spl = gridDim.x > 48; const int nsb = spl ? (int)gridDim.x - 24 : (int)gridDim.x, vb = spl ? (int)blockIdx.x - 24 : (int)blockIdx.x;
    if (vb < 0) return;
    { unsigned* nmax = (unsigned*)(ws + WS_CTRL) + 16; const bf16_t* Zq = (const bf16_t*)(ws + WS_Z);
      const int gtn = vb * NT + tid, pr = gtn & 127, hq = pr >> 4, rst = (nsb * NT) >> 7;
      for (int bb = 0; bb < 2; ++bb) { float mxq = 0.f, mxk = 0.f, mnd = 3.0e38f;
          for (int r = bb * SEQ + (gtn >> 7); r < (bb + 1) * SEQ; r += 4 * rst) { u32x4 zq[4], zk[4];
#pragma unroll
              for (int i = 0; i < 4; ++i) { const bool ok = r + i * rst < (bb + 1) * SEQ; const bf16_t* rp = Zq + (size_t)(r + i * rst) * ZP + 8 * pr;
                  zq[i] = ok ? *(const u32x4*)rp : (u32x4){0u, 0u, 0u, 0u}; zk[i] = ok ? *(const u32x4*)(rp + 1024) : (u32x4){0u, 0u, 0u, 0u}; }
#pragma unroll
              for (int i = 0; i < 4; ++i) { float sq = 0.f, sk = 0.f, sd = 0.f;
#pragma unroll
                  for (int q = 0; q < 4; ++q) { const float ql = __uint_as_float(zq[i][q] << 16), qh = __uint_as_float(zq[i][q] & 0xffff0000u), kl = __uint_as_float(zk[i][q] << 16), kh = __uint_as_float(zk[i][q] & 0xffff0000u);
                      sq += ql * ql + qh * qh; sk += kl * kl + kh * kh; sd += ql * kl + qh * kh; }
#pragma unroll
                  for (int o = 1; o < 2; ++o) { sq = row16_sum(sq); sk = row16_sum(sk); sd = row16_sum(sd); }
                  mxq = fmaxf(mxq, sq); mxk = fmaxf(mxk, sk); if (r + i * rst < (bb + 1) * SEQ) mnd = fminf(mnd, sd); } }
          if ((pr & 15) == 0) { atomicMax(nmax + bb * 16 + hq, __float_as_uint(mxq)); atomicMax(nmax + bb * 16 + 8 + hq, __float_as_uint(mxk));
              const unsigned db = __float_as_uint(mnd); atomicMin(nmax + 32 + bb * 8 + hq, db ^ ((db >> 31) ? 0xFFFFFFFFu : 0x80000000u)); } } }
    const bf16_t* Z = (const bf16_t*)(ws + WS_Z); bf16_t* QKc = (bf16_t*)(ws + WS_QKC);
    const int gt = vb * NT + tid, cgp = gt & 127, c0 = 8 * cgp;
    float cw[4][8], cb[8];
#pragma unroll
    for (int i = 0; i < 8; ++i) { cb[i] = p.conv_b[c0 + i];
#pragma unroll
        for (int j = 0; j < 4; ++j) cw[j][i] = p.conv_w[j * 1024 + c0 + i]; }
    const float osc = c0 >= 512 ? RSQRT_DK : 1.0f;
    for (int rb = gt >> 7; rb < T / 4; rb += (nsb * NT) >> 7) {
        const int r0 = 4 * rb, t0 = r0 & (SEQ - 1);
        u32x4 z[7];
#pragma unroll
        for (int j = 0; j < 7; ++j) z[j] = (t0 - 3 + j >= 0) ? *(const u32x4*)(Z + (size_t)(r0 - 3 + j) * ZP + 3072 + c0) : (u32x4){0u, 0u, 0u, 0u};
#pragma unroll
        for (int rr = 0; rr < 4; ++rr) {
            float a[8];
#pragma unroll
            for (int i = 0; i < 8; ++i) a[i] = cb[i];
#pragma unroll
            for (int j = 0; j < 4; ++j) {
#pragma unroll
                for (int q = 0; q < 4; ++q) { a[2 * q] += cw[j][2 * q] * __uint_as_float(z[rr + j][q] << 16); a[2 * q + 1] += cw[j][2 * q + 1] * __uint_as_float(z[rr + j][q] & 0xffff0000u); } }
            u32x4 o;
#pragma unroll
            for (int q = 0; q < 4; ++q) o[q] = pk2(pg8::silu_f(a[2 * q]) * osc, pg8::silu_f(a[2 * q + 1]) * osc);
            *(u32x4*)(QKc + (size_t)(r0 + rr) * 1024 + c0) = o;
        }
    }
}

__device__ __forceinline__ void p7_mlstm_local(const Params& p, LAS unsigned char* lds) {
    int tid_l = threadIdx.x; asm volatile("" : "+v"(tid_l)); const int tid = tid_l, lane = tid & 63, wave = __builtin_amdgcn_readfirstlane(tid >> 6), fr = lane & 15, fq = lane >> 4;
    unsigned char* ws = p.ws;
    const float* gates = (const float*)(ws + WS_GATES); const float* bcs = (const float*)(ws + WS_BCS); const float* scal = (const float*)(ws + WS_SCAL);
    const bf16_t* Z = (const bf16_t*)(ws + WS_Z); const bf16_t* QKc = (const bf16_t*)(ws + WS_QKC);
    bf16_t* Cst = (bf16_t*)(ws + WS_CST); float* nst = (float*)(ws + WS_NST);
    { const int gi = blockIdx.x * NT + tid;
      if (gi < 1024) { const int bhq = gi >> 6, qb = gi & 63, bq = bhq >> 3, hq = bhq & 7; const unsigned* nmax = (const unsigned*)(ws + WS_CTRL) + 16;
          const float qn2 = __uint_as_float(nmax[bq * 16 + hq]), kn2 = __uint_as_float(nmax[bq * 16 + 8 + hq]);
          const unsigned dk_ = nmax[32 + bq * 8 + hq]; const float dmin = __uint_as_float(dk_ ^ ((dk_ >> 31) ? 0x80000000u : 0xFFFFFFFFu));
          const float M = (105.0f + (1.01f * sqrtf(qn2 * kn2) - fminf(dmin, 0.f) * 1.01f + fmaxf(dmin, 0.f) * 0.0f) * RSQRT_DK) * SQRT_DH;
          const float* F = (const float*)(ws + WS_FS) + (size_t)bhq * SEQ; const float f0 = F[qb * 256];
          int lo = 0, hi = 4 * qb;
          while (lo < hi) { const int mid = (lo + hi) >> 1; if (f0 - F[64 * mid + 63] < -M) lo = mid + 1; else hi = mid; }
          ((int*)(ws + WS_CTRL + 1024))[gi] = lo; } }
    LAS bf16_t* wKt = (LAS bf16_t*)lds;
    LAS bf16_t* Vt = (LAS bf16_t*)(lds + 18432);
    LAS float* wts = (LAS float*)(lds + 55296);
    LAS float* nred = (LAS float*)(lds + 55808);
    u32x4 kreg[2], vreg[4]; float sreg[4] = {0.f, 0.f, 0.f, 0.f};
#define P7_LOAD(u_) do { const int bh_ = (u_) >> 8, k_ = (u_) & 255, b_ = bh_ >> 2, h_ = bh_ & 3; const size_t r0_ = (size_t)b_ * SEQ + 64 * k_; \
        if (tid < 64) { const float* bp_ = bcs + (size_t)bh_ * SEQ + 64 * k_; sreg[0] = bp_[63]; sreg[1] = bp_[tid]; sreg[2] = gates[(r0_ + tid) * 16 + 8 + h_]; sreg[3] = scal[(size_t)(u_) * 4 + 1]; } \
        _Pragma("unroll") for (int i = 0; i < 2; ++i) { const int pc = tid + NT * i, s = pc >> 4, d0 = (pc & 15) * 8; kreg[i] = *(const u32x4*)(QKc + (r0_ + s) * 1024 + 512 + 128 * h_ + d0); } \
        _Pragma("unroll") for (int i = 0; i < 4; ++i) { const int pc = tid + NT * i, s = pc >> 5, v0 = (pc & 31) * 8; vreg[i] = *(const u32x4*)(Z + (r0_ + s) * ZP + 4096 + 256 * h_ + v0); } } while (0)
    if ((int)blockIdx.x < 2048) P7_LOAD((int)blockIdx.x);
    for (int u = blockIdx.x; u < 2048; u += gridDim.x) {
        if (tid < 64) wts[tid] = __expf(sreg[0] - sreg[1] + sreg[2] - sreg[3]);
        LDS_BARRIER();
#pragma unroll
        for (int i = 0; i < 2; ++i) { const int pc = tid + NT * i, s = pc >> 4, d0 = (pc & 15) * 8; const float w = wts[s];
            const u32x4 kv = kreg[i];
#pragma unroll
            for (int q = 0; q < 4; ++q) { const unsigned pr = pk2(__uint_as_float(kv[q] << 16) * w, __uint_as_float(kv[q] & 0xffff0000u) * w);
                wKt[tsw(d0 + 2 * q, s)] = (bf16_t)(pr & 0xffffu); wKt[tsw(d0 + 2 * q + 1, s)] = (bf16_t)(pr >> 16); } }
#pragma unroll
        for (int i = 0; i < 4; ++i) { const int pc = tid + NT * i, s = pc >> 5, v0 = (pc & 31) * 8;
            const u32x4 vv = vreg[i];
#pragma unroll
            for (int q = 0; q < 4; ++q) { Vt[tsw(v0 + 2 * q, s)] = (bf16_t)(vv[q] & 0xffffu); Vt[tsw(v0 + 2 * q + 1, s)] = (bf16_t)(vv[q] >> 16); } }
        if (u + (int)gridDim.x < 2048) P7_LOAD(u + (int)gridDim.x);
        LDS_BARRIER();
        f32x4 acc[8][2];
#pragma unroll
        for (int dt = 0; dt < 8; ++dt) { acc[dt][0] = (f32x4){0.f, 0.f, 0.f, 0.f}; acc[dt][1] = (f32x4){0.f, 0.f, 0.f, 0.f}; }
#pragma unroll
        for (int ks = 0; ks < 2; ++ks) {
            bf16x8 bfr[2];
#pragma unroll
            for (int vt = 0; vt < 2; ++vt) bfr[vt] = *(const LAS bf16x8*)(Vt + tsw(32 * wave + 16 * vt + fr, 32 * ks + 8 * fq));
#pragma unroll
            for (int dt = 0; dt < 8; ++dt) { const bf16x8 a = *(const LAS bf16x8*)(wKt + tsw(16 * dt + fr, 32 * ks + 8 * fq));
                acc[dt][0] = __builtin_amdgcn_mfma_f32_16x16x32_bf16(a, bfr[0], acc[dt][0], 0, 0, 0);
                acc[dt][1] = __builtin_amdgcn_mfma_f32_16x16x32_bf16(a, bfr[1], acc[dt][1], 0, 0, 0); }
        }
        bf16_t* co = Cst + (size_t)u * 32768;
#pragma unroll
        for (int dt = 0; dt < 8; ++dt)
#pragma unroll
            for (int vt = 0; vt < 2; ++vt) { u32x2 w; w.x = pk2(acc[dt][vt][0], acc[dt][vt][1]); w.y = pk2(acc[dt][vt][2], acc[dt][vt][3]);
                *(u32x2*)(co + (size_t)(32 * wave + 16 * vt + fr) * 128 + 16 * dt + 4 * fq) = w; }
        { const int d = tid & 127, part = tid >> 7; float s = 0.f;
#pragma unroll
            for (int i = 0; i < 16; ++i) s += bf2f(wKt[tsw(d, 16 * part + i)]);
            nred[part * 128 + d] = s; }
        LDS_BARRIER();
        if (tid < 128) nst[(size_t)u * 128 + tid] = (nred[tid] + nred[128 + tid]) + (nred[256 + tid] + nred[384 + tid]);
        LDS_BARRIER();
    }
#undef P7_LOAD
}

constexpr int SCAN_CHUNKS = 258;
__device__ __forceinline__ void p8_scan_chunk(const Params& p, int chunk) {
    unsigned char* ws = p.ws; const float* scal = (const float*)(ws + WS_SCAL);
    unsigned* Cst = (unsigned*)(ws + WS_CST); float* nst = (float*)(ws + WS_NST);
    if (chunk < 256) { const int it = chunk * NT + (int)threadIdx.x;
        const int bh = it >> 14, e = it & 16383; unsigned* cp = Cst + (size_t)bh * 256 * 16384 + e; const float* sp = scal + (size_t)bh * 256 * 4 + 2;
        float s0 = 0.f, s1 = 0.f;
        for (int k0 = 0; k0 < 256; k0 += 8) { unsigned loc[8]; float dk[8];
#pragma unroll
            for (int j = 0; j < 8; ++j) { loc[j] = cp[(size_t)(k0 + j) * 16384]; dk[j] = sp[(k0 + j) * 4]; }
#pragma unroll
            for (int j = 0; j < 8; ++j) { cp[(size_t)(k0 + j) * 16384] = pk2(s0, s1);
                s0 = dk[j] * s0 + __uint_as_float(loc[j] << 16); s1 = dk[j] * s1 + __uint_as_float(loc[j] & 0xffff0000u); } }
    } else { const int it = (chunk - 256) * NT + (int)threadIdx.x; const int bh = it >> 7, d = it & 127; float* np = nst + (size_t)bh * 256 * 128 + d; const float* sp = scal + (size_t)bh * 256 * 4 + 2;
        float s = 0.f;
        for (int k0 = 0; k0 < 256; k0 += 16) { float loc[16], dk[16];
#pragma unroll
            for (int j = 0; j < 16; ++j) { loc[j] = np[(k0 + j) * 128]; dk[j] = sp[(k0 + j) * 4]; }
#pragma unroll
            for (int j = 0; j < 16; ++j) { np[(k0 + j) * 128] = s; s = dk[j] * s + loc[j]; } } }
}
__device__ __forceinline__ void p9_mlstm_out(const Params& p, LAS unsigned char* lds) {
    int tid_l = threadIdx.x; asm volatile("" : "+v"(tid_l)); const int tid = tid_l, lane = tid & 63, wave = __builtin_amdgcn_readfirstlane(tid >> 6), fr = lane & 15, fq = lane >> 4;
    unsigned char* ws = p.ws;
    const float* gates = (const float*)(ws + WS_GATES); const float* bcs = (const float*)(ws + WS_BCS); const float* scal = (const float*)(ws + WS_SCAL);
    const bf16_t* Z = (const bf16_t*)(ws + WS_Z); const bf16_t* QKc = (const bf16_t*)(ws + WS_QKC);
    const bf16_t* Cst = (const bf16_t*)(ws + WS_CST); const float* nst = (const float*)(ws + WS_NST); bf16_t* Y = (bf16_t*)(ws + WS_A);
    LAS bf16_t* Qs = (LAS bf16_t*)lds;
    LAS bf16_t* Ks = (LAS bf16_t*)(lds + 17408);
    LAS bf16_t* Vt = (LAS bf16_t*)(lds + 34816);
    LAS bf16_t* St = (LAS bf16_t*)(lds + 71680);
    LAS float* fb = (LAS float*)(lds + 80896);
    LAS float* bt = fb; LAS float* ig = fb + 64; LAS float* mt = fb + 128; LAS float* inter = fb + 192; LAS float* scl = fb + 256; LAS float* ssq = fb + 320; LAS float* nprev = fb + 384; LAS float* ssqw = fb + 512;
    u32x4 qreg[2], kreg[2], vreg[4]; float sreg[2] = {0.f, 0.f}; float mpn = 0.f;
#define P9_LOAD(u_) do { const int bh_ = (u_) >> 8, k_ = (u_) & 255, b_ = bh_ >> 2, h_ = bh_ & 3; const size_t r0_ = (size_t)b_ * SEQ + 64 * k_; \
        _Pragma("unroll") for (int i = 0; i < 2; ++i) { const int pc = tid + NT * i, s = pc >> 4, d0 = (pc & 15) * 8; \
            qreg[i] = *(const u32x4*)(QKc + (r0_ + s) * 1024 + 128 * h_ + d0); kreg[i] = *(const u32x4*)(QKc + (r0_ + s) * 1024 + 512 + 128 * h_ + d0); } \
        _Pragma("unroll") for (int i = 0; i < 4; ++i) { const int pc = tid + NT * i, s = pc >> 5, v0 = (pc & 31) * 8; vreg[i] = *(const u32x4*)(Z + (r0_ + s) * ZP + 4096 + 256 * h_ + v0); } \
        mpn = scal[(size_t)(u_) * 4 + 0]; \
        if (tid < 64) { sreg[0] = bcs[(size_t)bh_ * SEQ + 64 * k_ + tid]; sreg[1] = gates[(r0_ + tid) * 16 + 8 + h_]; } \
        else if (tid < 192) sreg[0] = nst[(size_t)(u_) * 128 + (tid - 64)]; } while (0)
    if ((int)blockIdx.x < 2048) P9_LOAD((int)blockIdx.x);
    for (int u = blockIdx.x; u < 2048; u += gridDim.x) {
        const int bh = u >> 8, k = u & 255, b = bh >> 2, h = bh & 3; const size_t row0 = (size_t)b * SEQ + 64 * k;
        const float mprev = mpn;
        bf16x8 cfr[2][4];
#pragma unroll
        for (int vt = 0; vt < 2; ++vt)
#pragma unroll
            for (int ks = 0; ks < 4; ++ks) cfr[vt][ks] = *(const bf16x8*)(Cst + (size_t)u * 32768 + (size_t)(32 * wave + 16 * vt + fr) * 128 + 32 * ks + 8 * fq);
#pragma unroll
        for (int i = 0; i < 2; ++i) { const int pc = tid + NT * i, s = pc >> 4, d0 = (pc & 15) * 8;
            *(LAS u32x4*)(Qs + s * 136 + d0) = qreg[i]; *(LAS u32x4*)(Ks + s * 136 + d0) = kreg[i]; }
#pragma unroll
        for (int i = 0; i < 4; ++i) { const int pc = tid + NT * i, s = pc >> 5, v0 = (pc & 31) * 8;
            const u32x4 vv = vreg[i];
#pragma unroll
            for (int q = 0; q < 4; ++q) { Vt[tsw(v0 + 2 * q, s)] = (bf16_t)(vv[q] & 0xffffu); Vt[tsw(v0 + 2 * q + 1, s)] = (bf16_t)(vv[q] >> 16); } }
        if (tid < 64) { bt[tid] = sreg[0]; ig[tid] = sreg[1];
            float pm = sreg[1] - sreg[0];
#pragma unroll
            for (int o = 1; o < 64; o <<= 1) { const float v = __shfl_up(pm, o); if (lane >= o) pm = fmaxf(pm, v); }
            const float mx = sreg[0] + fmaxf(mprev, pm); mt[tid] = mx; inter[tid] = __expf(sreg[0] + mprev - mx); }
        else if (tid < 192) nprev[tid - 64] = sreg[0];
        if (u + (int)gridDim.x < 2048) P9_LOAD(u + (int)gridDim.x);
        LDS_BARRIER();
        const int st = wave >> 1, tt0 = 2 * (wave & 1);
        f32x4 sacc[2] = {{0.f, 0.f, 0.f, 0.f}, {0.f, 0.f, 0.f, 0.f}};
#pragma unroll
        for (int ks = 0; ks < 4; ++ks) { const bf16x8 a = *(const LAS bf16x8*)(Ks + (16 * st + fr) * 136 + 32 * ks + 8 * fq);
#pragma unroll
            for (int j = 0; j < 2; ++j) { const bf16x8 bq = *(const LAS bf16x8*)(Qs + (16 * (tt0 + j) + fr) * 136 + 32 * ks + 8 * fq);
                sacc[j] = __builtin_amdgcn_mfma_f32_16x16x32_bf16(a, bq, sacc[j], 0, 0, 0); } }
        LDS_BARRIER();
#pragma unroll
        for (int j = 0; j < 2; ++j) { const int t = 16 * (tt0 + j) + fr; const float base = bt[t] - mt[t]; float o[4];
#pragma unroll
            for (int i = 0; i < 4; ++i) { const int s = 16 * st + 4 * fq + i; o[i] = (s <= t) ? sacc[j][i] * __expf(base - bt[s] + ig[s]) : 0.f; }
            u32x2 w; w.x = pk2(o[0], o[1]); w.y = pk2(o[2], o[3]); *(LAS u32x2*)(St + t * 72 + 16 * st + 4 * fq) = w; }
        LDS_BARRIER();
        u32x2 obr[4][2]; f32x4 gr[2];
#pragma unroll
        for (int vt = 0; vt < 2; ++vt) { const int v = 32 * wave + 16 * vt + 4 * fq; gr[vt] = *(const f32x4*)(p.ml_ng + 256 * h + v);
#pragma unroll
            for (int tt = 0; tt < 4; ++tt) obr[tt][vt] = *(const u32x2*)(Z + (row0 + 16 * tt + fr) * ZP + 5120 + 256 * h + v); }
        { const int t = tid >> 3, part = tid & 7; float rs = 0.f, qn = 0.f;
            { const u32x4 sv = *(const LAS u32x4*)(St + t * 72 + 8 * part);
#pragma unroll
              for (int i = 0; i < 4; ++i) rs += __uint_as_float(sv[i] << 16) + __uint_as_float(sv[i] & 0xffff0000u); }
#pragma unroll
            for (int hq = 0; hq < 2; ++hq) { const u32x4 qv = *(const LAS u32x4*)(Qs + t * 136 + 16 * part + 8 * hq);
#pragma unroll
              for (int i = 0; i < 4; ++i) { const f32x4 nv = *(const LAS f32x4*)(nprev + 16 * part + 8 * hq + 4 * (i >> 1));
                  qn += __uint_as_float(qv[i] << 16) * nv[2 * (i & 1)] + __uint_as_float(qv[i] & 0xffff0000u) * nv[2 * (i & 1) + 1]; } }
            rs = oct_sum(rs); qn = oct_sum(qn);
            if (part == 0) { const float den = inter[t] * qn + rs; scl[t] = 1.0f / fmaxf(fabsf(den), __expf(-mt[t])); ssq[t] = 0.f; } }
        f32x4 acc[2][4];
#pragma unroll
        for (int vt = 0; vt < 2; ++vt)
#pragma unroll
            for (int tt = 0; tt < 4; ++tt) acc[vt][tt] = (f32x4){0.f, 0.f, 0.f, 0.f};
#pragma unroll
        for (int ks = 0; ks < 4; ++ks)
#pragma unroll
            for (int tt = 0; tt < 4; ++tt) { const bf16x8 bq = *(const LAS bf16x8*)(Qs + (16 * tt + fr) * 136 + 32 * ks + 8 * fq);
                acc[0][tt] = __builtin_amdgcn_mfma_f32_16x16x32_bf16(cfr[0][ks], bq, acc[0][tt], 0, 0, 0);
                acc[1][tt] = __builtin_amdgcn_mfma_f32_16x16x32_bf16(cfr[1][ks], bq, acc[1][tt], 0, 0, 0); }
#pragma unroll
        for (int tt = 0; tt < 4; ++tt) { const float it = inter[16 * tt + fr]; acc[0][tt] = acc[0][tt] * it; acc[1][tt] = acc[1][tt] * it; }
#pragma unroll
        for (int ks = 0; ks < 2; ++ks) { bf16x8 av[2];
#pragma unroll
            for (int vt = 0; vt < 2; ++vt) av[vt] = *(const LAS bf16x8*)(Vt + tsw(32 * wave + 16 * vt + fr, 32 * ks + 8 * fq));
#pragma unroll
            for (int tt = 0; tt < 4; ++tt) { const bf16x8 bs = *(const LAS bf16x8*)(St + (16 * tt + fr) * 72 + 32 * ks + 8 * fq);
                acc[0][tt] = __builtin_amdgcn_mfma_f32_16x16x32_bf16(av[0], bs, acc[0][tt], 0, 0, 0);
                acc[1][tt] = __builtin_amdgcn_mfma_f32_16x16x32_bf16(av[1], bs, acc[1][tt], 0, 0, 0); } }
        LDS_BARRIER();
#pragma unroll
        for (int tt = 0; tt < 4; ++tt) { const float sc = scl[16 * tt + fr]; float q = 0.f;
#pragma unroll
            for (int vt = 0; vt < 2; ++vt) { acc[vt][tt] = acc[vt][tt] * sc; q += (acc[vt][tt][0] * acc[vt][tt][0] + acc[vt][tt][1] * acc[vt][tt][1]) + (acc[vt][tt][2] * acc[vt][tt][2] + acc[vt][tt][3] * acc[vt][tt][3]); }
            q = swap32_sum(swap16_sum(q));
            if (fq == 0) ssqw[wave * 64 + 16 * tt + fr] = q; }
        LDS_BARRIER();
        if (tid < 64) { float s = 0.f;
#pragma unroll
            for (int w = 0; w < 8; ++w) s += ssqw[w * 64 + tid];
            ssq[tid] = s; }
        LDS_BARRIER();
#pragma unroll
        for (int tt = 0; tt < 4; ++tt) { const int t = 16 * tt + fr; const float rn = 1.0f / sqrtf(ssq[t] * (1.f / 256.f) + LN_EPS);
#pragma unroll
            for (int vt = 0; vt < 2; ++vt) { const int v = 32 * wave + 16 * vt + 4 * fq;
                const f32x4 g = gr[vt]; const u32x2 ob = obr[tt][vt];
                const f32x4 y = acc[vt][tt] * rn * g;
                u32x2 w; w.x = pk2(y[0] * __uint_as_float(ob.x << 16), y[1] * __uint_as_float(ob.x & 0xffff0000u)); w.y = pk2(y[2] * __uint_as_float(ob.y << 16), y[3] * __uint_as_float(ob.y & 0xffff0000u));
                *(u32x2*)(Y + (row0 + t) * DM + 1024 + 256 * h + v) = w; } }
        LDS_BARRIER();
    }
#undef P9_LOAD
}
}
namespace fa {
constexpr int D = 128, KVP = 6144, OP = 2048;
constexpr float THR = 8.f;
constexpr bool WSKIP = false;
constexpr float SCALE = 0.08838834764831845f;
constexpr int NW = 8, QBLK = 32, KVBLK = 64, QB = NW * QBLK;
constexpr int SHM_V = KVBLK * D * 2, SHM_K = KVBLK * D * 2;
constexpr int LDS_BYTES = 2 * SHM_V + 2 * SHM_K + NW * 64 * 4;
constexpr int FL_OFF = 69632;
using bf16 = __hip_bfloat16;
typedef short bf16x8 __attribute__((ext_vector_type(8)));
typedef short s16x4 __attribute__((ext_vector_type(4)));
typedef float f32x16 __attribute__((ext_vector_type(16)));
typedef float f32x4 __attribute__((ext_vector_type(4)));
typedef unsigned u32x4 __attribute__((ext_vector_type(4)));
template <class A, class Bt> struct same_t { static constexpr bool v = false; };
template <class A> struct same_t<A, A> { static constexpr bool v = true; };

#define KSWZ(row, colB) ((row) * 256 + ((colB) ^ (((row) & 7) << 4)))
#define SBAR() __builtin_amdgcn_sched_barrier(0)
__device__ __forceinline__ int v_st(int k, int c) { const int kk = (k & ~0xC) | ((k & 4) << 1) | ((k & 8) >> 1); return ((kk >> 3) * 4 + (c >> 5)) * 512 + ((kk & 7) * 32 + (c & 31)) * 2; }
__device__ __forceinline__ int v_rd_base(int lane) { return ((lane & 3) << 3) | (((lane >> 2) & 3) << 6) | (((lane >> 4) & 1) << 5) | (((lane >> 5) & 1) << 8); }
constexpr int v_rd_off(int d0, int ks, int half) { return d0 * 512 + ks * 4096 + half * 2048; }
__device__ __forceinline__ int crow(int r, int hi) { return (r & 3) + 8 * (r >> 2) + 4 * hi; }
__device__ __forceinline__ unsigned cvtpk(float lo, float hi) { return pg8::cvt_pk_bf16(lo, hi); }
__device__ __forceinline__ bf16x8 pack8(f32x4 a, f32x4 b) {
    u32x4 w = {cvtpk(a[0], a[1]), cvtpk(a[2], a[3]), cvtpk(b[0], b[1]), cvtpk(b[2], b[3])};
    return *reinterpret_cast<bf16x8*>(&w);
}
template <class T> __device__ __forceinline__ bf16x8 load8(const T* p) {
    if constexpr (same_t<T, float>::v) { return pack8(*(const f32x4*)p, *(const f32x4*)(p + 4)); }
    else { return *reinterpret_cast<const bf16x8*>(p); }
}
__device__ __forceinline__ void split3(float x, unsigned& h, unsigned& m, unsigned& l) {
    const unsigned xb = __float_as_uint(x); h = xb >> 16; const float r = x - __uint_as_float(xb & 0xffff0000u);
    const unsigned rb = __float_as_uint(r); m = rb >> 16; const float r2 = r - __uint_as_float(rb & 0xffff0000u);
    l = __float_as_uint(r2) >> 16;
}
__device__ __forceinline__ bf16x8 aug_q(float x, int hi) { unsigned h, m, l; split3(x, h, m, l);
    u32x4 w = {h | (m << 16), l | 0x3F800000u, 0x3F803F80u, 0u}; if (hi) w = u32x4{0u, 0u, 0u, 0u}; return *reinterpret_cast<bf16x8*>(&w); }
__device__ __forceinline__ bf16x8 aug_k(float x, int hi) { unsigned h, m, l; split3(x, h, m, l);
    u32x4 w = {0x3F803F80u, 0x3F80u | (h << 16), m | (l << 16), 0u}; if (hi) w = u32x4{0u, 0u, 0u, 0u}; return *reinterpret_cast<bf16x8*>(&w); }
__device__ __forceinline__ void mask_tile(f32x16& p0, f32x16& p1, int dq, unsigned W) {
    const float NEG = -__builtin_inff();
#pragma unroll
    for (int r = 0; r < 16; ++r) {
        const int c = (r & 3) + 8 * (r >> 2);
        if ((unsigned)(dq - c) >= W) p0[r] = NEG;
        if ((unsigned)(dq - c - 32) >= W) p1[r] = NEG;
    }
}
__device__ __forceinline__ void partialSM(f32x16& p0, f32x16& p1, float& m_reg, float& mn, float& alpha) {
    float pmax = p0[0]; for (int r = 1; r < 16; ++r) pmax = fmaxf(pmax, p0[r]); for (int r = 0; r < 16; ++r) pmax = fmaxf(pmax, p1[r]);
    { auto rr = __builtin_amdgcn_permlane32_swap(__float_as_uint(pmax), __float_as_uint(pmax), false, false);
      pmax = fmaxf(__uint_as_float(rr[0]), __uint_as_float(rr[1])); }
    constexpr float C2 = 1.4426950408889634f * SCALE;
    if (__builtin_expect(__all((pmax - m_reg) * SCALE <= THR), 1)) { mn = m_reg; alpha = 1.f; }
    else { mn = fmaxf(m_reg, pmax); alpha = __builtin_amdgcn_exp2f((m_reg - mn) * C2); m_reg = mn; }
    const float mnL = -mn * C2;
    for (int r = 0; r < 16; ++r) p0[r] = fmaf(p0[r], C2, mnL); for (int r = 0; r < 16; ++r) p1[r] = fmaf(p1[r], C2, mnL);
    for (int r = 0; r < 16; ++r) p0[r] = __builtin_amdgcn_exp2f(p0[r]);
}
__device__ __forceinline__ void finishSM(f32x16& p0, f32x16& p1, float alpha, float& l_reg, bf16x8& pa0, bf16x8& pa1, bf16x8& pa2, bf16x8& pa3) {
    for (int r = 0; r < 16; ++r) p1[r] = __builtin_amdgcn_exp2f(p1[r]);
    float ps = 0; for (int r = 0; r < 16; ++r) ps += p0[r]; for (int r = 0; r < 16; ++r) ps += p1[r];
    { auto rr = __builtin_amdgcn_permlane32_swap(__float_as_uint(ps), __float_as_uint(ps), false, false);
      ps = __uint_as_float(rr[0]) + __uint_as_float(rr[1]); }
    l_reg = l_reg * alpha + ps;
#define PK4(P, B_, OUT) do { unsigned a0 = cvtpk(P[B_+0], P[B_+1]), a1 = cvtpk(P[B_+2], P[B_+3]);                          \
        unsigned b0 = cvtpk(P[B_+4], P[B_+5]), b1 = cvtpk(P[B_+6], P[B_+7]);                                             \
        auto r0 = __builtin_amdgcn_permlane32_swap(a0, b0, false, false); auto r1 = __builtin_amdgcn_permlane32_swap(a1, b1, false, false); \
        u32x4 w = {r0[0], r1[0], r0[1], r1[1]}; OUT = *reinterpret_cast<bf16x8*>(&w); } while (0)
    PK4(p0, 0, pa0); PK4(p0, 8, pa1); PK4(p1, 0, pa2); PK4(p1, 8, pa3);
#undef PK4
}
template <int KB, bool SK>
__device__ __forceinline__ void qkt(f32x16& p0, f32x16& p1, const char* K_lds, int r32, int hi, const bf16x8* qr, bool act, bf16x8 qaug, bf16x8 ka0, bf16x8 ka1) {
    if (SK && !act) { const float NEG = -__builtin_inff();
#pragma unroll
        for (int r = 0; r < 16; ++r) { p0[r] = NEG; p1[r] = NEG; } return; }
    p0 = f32x16{}; p1 = f32x16{};
    p0 = __builtin_amdgcn_mfma_f32_32x32x16_bf16(ka0, qaug, p0, 0, 0, 0); p1 = __builtin_amdgcn_mfma_f32_32x32x16_bf16(ka1, qaug, p1, 0, 0, 0);
    const char* kb[4];
#pragma unroll
    for (int dd = 0; dd < 4; ++dd) kb[dd] = K_lds + KB * SHM_K + KSWZ(r32, (dd * 16 + hi * 8) * 2);
#pragma unroll
    for (int d0 = 0; d0 < 8; ++d0) { const char* a = kb[d0 & 3] + (d0 >> 2) * 128;
        bf16x8 b0 = *reinterpret_cast<const bf16x8*>(a);
        bf16x8 b1 = *reinterpret_cast<const bf16x8*>(a + 32 * 256);
        p0 = __builtin_amdgcn_mfma_f32_32x32x16_bf16(b0, qr[d0], p0, 0, 0, 0);
        p1 = __builtin_amdgcn_mfma_f32_32x32x16_bf16(b1, qr[d0], p1, 0, 0, 0); }
}
template <int VB, bool SK>
__device__ __forceinline__ void pv_tile(f32x16* o, int vb0, bf16x8 pa0, bf16x8 pa1, bf16x8 pa2, bf16x8 pa3, bool act) {
    if (SK && !act) return;
#define TRRD(dst, off) asm volatile("ds_read_b64_tr_b16 %0, %1 offset:%2" : "=&v"(dst) : "v"(vb0), "i"(off) : "memory")
#define PV_D0(d0) do { s16x4 l0, l1, l2, l3, h0, h1, h2, h3; constexpr int b_ = VB * SHM_V + v_rd_off(d0, 0, 0);     \
        TRRD(l0, b_); TRRD(h0, b_ + 2048); TRRD(l1, b_ + 4096); TRRD(h1, b_ + 6144); TRRD(l2, b_ + 8192); TRRD(h2, b_ + 10240); TRRD(l3, b_ + 12288); TRRD(h3, b_ + 14336); \
        asm volatile("s_waitcnt lgkmcnt(0)" ::: "memory"); SBAR();                 \
        o[d0] = __builtin_amdgcn_mfma_f32_32x32x16_bf16(pa0, (bf16x8){l0[0], l0[1], l0[2], l0[3], h0[0], h0[1], h0[2], h0[3]}, o[d0], 0, 0, 0);   \
        o[d0] = __builtin_amdgcn_mfma_f32_32x32x16_bf16(pa1, (bf16x8){l1[0], l1[1], l1[2], l1[3], h1[0], h1[1], h1[2], h1[3]}, o[d0], 0, 0, 0);   \
        o[d0] = __builtin_amdgcn_mfma_f32_32x32x16_bf16(pa2, (bf16x8){l2[0], l2[1], l2[2], l2[3], h2[0], h2[1], h2[2], h2[3]}, o[d0], 0, 0, 0);   \
        o[d0] = __builtin_amdgcn_mfma_f32_32x32x16_bf16(pa3, (bf16x8){l3[0], l3[1], l3[2], l3[3], h3[0], h3[1], h3[2], h3[3]}, o[d0], 0, 0, 0); } while (0)
    PV_D0(0); PV_D0(1); PV_D0(2); PV_D0(3);
#undef PV_D0
#undef TRRD
}

template <class TIn, class TOut> struct BlockRef { const TIn* Q; const TIn* K; const TIn* V; TOut* O; const float* F; int P0; int jlo; };
template <class TIn> struct Seam {
    bf16x8 qr[8];
    bf16x8 st_v0, st_v1, st_k0, st_k1; f32x4 sf0, sf1, sf2, sf3;
    f32x4 tq[16];
};
__device__ __forceinline__ int swa_jlo(int P0, int W) { const int lowk = P0 - W + 1; return lowk > 0 ? lowk / KVBLK : 0; }
#define ROW(p, k0, rr) ((p) + (size_t)((k0) + (rr)) * KVP + sc)
#define VMW() asm volatile("s_waitcnt vmcnt(0)" ::: "memory")
#define VMWN(n) asm volatile("s_waitcnt vmcnt(%0)" :: "i"(n) : "memory")
#define SLOAD_H(Kp, Vp, k0) do { S.st_v0 = load8<TIn>(ROW(Vp, k0, sr)); S.st_v1 = load8<TIn>(ROW(Vp, k0, 32 + sr));              \
                         S.st_k0 = load8<TIn>(ROW(Kp, k0, sr)); S.st_k1 = load8<TIn>(ROW(Kp, k0, 32 + sr)); } while (0)
#define SWRITE_HK(bf) do { *(bf16x8*)(K_lds + (bf) * SHM_K + kws) = S.st_k0; *(bf16x8*)(K_lds + (bf) * SHM_K + kws + 32 * 256) = S.st_k1; } while (0)
#define SWRITE_HV(bf) do { *(bf16x8*)(V_lds + (bf) * SHM_V + vst0) = S.st_v0; *(bf16x8*)(V_lds + (bf) * SHM_V + vst1) = S.st_v1; } while (0)
#define SWRITE_H(bf) do { SWRITE_HV(bf); SWRITE_HK(bf); } while (0)
#define SLOAD_F(p, k0) do { S.sf0 = *(const f32x4*)ROW(p, k0, sr); S.sf1 = *(const f32x4*)(ROW(p, k0, sr) + 4);                \
                            S.sf2 = *(const f32x4*)ROW(p, k0, 32 + sr); S.sf3 = *(const f32x4*)(ROW(p, k0, 32 + sr) + 4); } while (0)
#define SWRITE_KF(bf) do { *(bf16x8*)(K_lds + (bf) * SHM_K + kws) = pack8(S.sf0, S.sf1); *(bf16x8*)(K_lds + (bf) * SHM_K + kws + 32 * 256) = pack8(S.sf2, S.sf3); } while (0)
#define SWRITE_VF(bf) do { *(bf16x8*)(V_lds + (bf) * SHM_V + vst0) = pack8(S.sf0, S.sf1); *(bf16x8*)(V_lds + (bf) * SHM_V + vst1) = pack8(S.sf2, S.sf3); } while (0)
template <class TIn, class TOut>
__device__ __forceinline__ void causal_swa_prime(const BlockRef<TIn, TOut>& cur, int W, char* lds, Seam<TIn>& S) {
    constexpr bool F32 = same_t<TIn, float>::v;
    int tid_l = threadIdx.x; asm volatile("" : "+v"(tid_l)); const int tid = tid_l, wid = __builtin_amdgcn_readfirstlane(tid >> 6), lane = tid & 63, r32 = lane & 31, hi = lane >> 5;
    const int sr = tid >> 4, sc = (tid & 15) * 8, kws = KSWZ(sr, sc * 2); char* K_lds = lds + 2 * SHM_V;
    const int kb0 = ((cur.P0 + QB - 1) / KVBLK) * KVBLK;
    for (int d0 = 0; d0 < 8; ++d0) S.qr[d0] = load8<TIn>(cur.Q + (size_t)(wid * QBLK + r32) * KVP + d0 * 16 + hi * 8);
    if constexpr (F32) { SLOAD_F((const float*)cur.K, kb0); VMW(); SWRITE_KF(0); SBAR(); SLOAD_F((const float*)cur.V, kb0); }
    else { SLOAD_H(cur.K, cur.V, kb0); VMW(); SWRITE_HK(0); }
    __syncthreads();
}
template <class TIn, class TOut>
__device__ __forceinline__ void causal_swa_block(const BlockRef<TIn, TOut>& cur, const BlockRef<TIn, TOut>& nxt, int skv, int W, char* lds, Seam<TIn>& S) {
    constexpr bool F32 = same_t<TIn, float>::v;
    int tid_l = threadIdx.x; asm volatile("" : "+v"(tid_l)); const int tid = tid_l, wid = __builtin_amdgcn_readfirstlane(tid >> 6), lane = tid & 63, r32 = lane & 31, hi = lane >> 5;
    const int j_lo = cur.jlo;
    int j_hi = (cur.P0 + QB - 1) / KVBLK + 1; if (j_hi > skv / KVBLK) j_hi = skv / KVBLK;
    const int NT = j_hi - j_lo;
    const int kbn = ((nxt.P0 + QB - 1) / KVBLK) * KVBLK;
    const int qlo = cur.P0 + wid * QBLK, qm = qlo + r32 - 4 * hi;
    float* Fl = (float*)(lds + FL_OFF);
    float fqv;
    { const float fbase = __uint_as_float(__builtin_amdgcn_readfirstlane(__float_as_uint(cur.F[cur.P0]))); fqv = cur.F[cur.P0 + wid * QBLK + r32] - fbase;
      for (int i4 = cur.jlo * (KVBLK / 4) + tid; i4 < (cur.P0 + QB) / 4; i4 += 64 * NW) { const f32x4 v = ((const f32x4*)cur.F)[i4]; ((f32x4*)Fl)[i4] = v - fbase; } }
    asm volatile("s_waitcnt lgkmcnt(0)" ::: "memory"); __builtin_amdgcn_s_barrier(); asm volatile("" ::: "memory");
#define KAUG(t_, a_, b_) const bf16x8 qaug = aug_q(fqv, hi), a_ = aug_k(-Fl[KBASE(t_) + r32], hi), b_ = aug_k(-Fl[KBASE(t_) + 32 + r32], hi)
#define FLOADK(t) do { } while (0)
    char* V_lds = lds; char* K_lds = lds + 2 * SHM_V;
    float* ws = (float*)(lds + 2 * SHM_V + 2 * SHM_K) + wid * 64; float* li_l = ws, * al_l = ws + 32;
    float m_reg = -1e30f, l_reg = 0; f32x16 o[4] = {};
    const int sr = tid >> 4, sc = (tid & 15) * 8, vst0 = v_st(sr, sc), vst1 = v_st(32 + sr, sc), kws = KSWZ(sr, sc * 2);
    const int vb0 = (int)(uintptr_t)V_lds + v_rd_base(lane);
    const TIn* Kh = cur.K; const TIn* Vh = cur.V;
#define RESC(a) do { if (__any((a) < 1.f)) { if (hi == 0) al_l[r32] = (a); asm volatile("s_waitcnt lgkmcnt(0)" ::: "memory");              \
                     for (int d_ = 0; d_ < 4; ++d_) for (int r = 0; r < 16; ++r) o[d_][r] *= al_l[crow(r, hi)]; } } while (0)
#define KBASE(t) ((j_hi - 1 - (t)) * KVBLK)
#define ACT(t) (KBASE(t) <= qlo + QBLK - 1 && KBASE(t) + KVBLK - 1 >= qlo - W + 1)
#define MASKT(P0_, P1_, t) do { const int kb_ = KBASE(t); if ((!SK || ACT(t)) && (kb_ + KVBLK - 1 > qlo || kb_ <= qlo + QBLK - 1 - W)) mask_tile(P0_, P1_, qm - kb_, (unsigned)W); } while (0)
    constexpr int NQL = F32 ? 16 : 8;
    constexpr bool SK = WSKIP && !F32;
#define SEAM_K0() do { VMWN(NQL); if constexpr (F32) { SWRITE_KF(0); SBAR(); SLOAD_F((const float*)nxt.V, kbn); } else { SWRITE_HK(0); } SBAR(); } while (0)
    f32x16 pA0, pA1, pB0, pB1; float mnA, mnB, alA, alB; bf16x8 pa0, pa1, pa2, pa3;
    if constexpr (F32) { VMW(); SWRITE_VF(0); SBAR(); } else { SWRITE_HV(0); SBAR(); }
    bf16x8 kh0, kh1, qaug0; { KAUG(0, a_, b_); kh0 = a_; kh1 = b_; qaug0 = qaug; }
    if (NT > 1) { if constexpr (F32) SLOAD_F((const float*)Kh, KBASE(1)); else SLOAD_H(Kh, Vh, KBASE(1)); FLOADK(1); }
    SBAR(); qkt<0, SK>(pA0, pA1, K_lds, r32, hi, S.qr, ACT(0), qaug0, kh0, kh1);
    if constexpr (F32) { if (NT > 1) { VMW(); SWRITE_KF(1); SBAR(); SLOAD_F((const float*)Vh, KBASE(1)); } }
    MASKT(pA0, pA1, 0); partialSM(pA0, pA1, m_reg, mnA, alA);
    if (NT > 1) { VMW(); if constexpr (F32) { SWRITE_VF(1); SBAR(); if (NT > 2) SLOAD_F((const float*)Kh, KBASE(2)); } else SWRITE_H(1); }
    __syncthreads();
#define HALF_STEP(PX0, PX1, mnX, alX, PY0, PY1, alY, t, KB, VB, SB) do {                                                      \
        SBAR(); { KAUG(t, kx0, kx1); qkt<KB, SK>(PX0, PX1, K_lds, r32, hi, S.qr, ACT(t), qaug, kx0, kx1); }                  \
        finishSM(PY0, PY1, alY, l_reg, pa0, pa1, pa2, pa3); SBAR();                                                           \
        if ((t) + 1 < NT) { if constexpr (F32) { VMW(); SWRITE_KF(SB); SBAR(); SLOAD_F((const float*)Vh, KBASE((t) + 1)); }  \
                            else { SLOAD_H(Kh, Vh, KBASE((t) + 1)); } FLOADK((t) + 1); SBAR(); }                                               \
        pv_tile<VB, SK>(o, vb0, pa0, pa1, pa2, pa3, ACT((t) - 1)); MASKT(PX0, PX1, (t)); partialSM(PX0, PX1, m_reg, mnX, alX);                                        \
        __syncthreads();                                                                                                      \
        if ((t) + 1 < NT) { VMW(); if constexpr (F32) { SWRITE_VF(SB); SBAR(); if ((t) + 2 < NT) SLOAD_F((const float*)Kh, KBASE((t) + 2)); } \
                            else { SWRITE_H(SB); } }                                                                          \
        RESC(alX); __syncthreads(); } while (0)
    for (int t = 1; t + 1 < NT; t += 2) {
        HALF_STEP(pB0, pB1, mnB, alB, pA0, pA1, alA, t, 1, 0, 0);
        HALF_STEP(pA0, pA1, mnA, alA, pB0, pB1, alB, t + 1, 0, 1, 1);
    }
    const bool even = (NT & 1) == 0;
    if (even) { SBAR(); KAUG(NT - 1, kt0, kt1); qkt<1, SK>(pB0, pB1, K_lds, r32, hi, S.qr, ACT(NT - 1), qaug, kt0, kt1); SBAR(); }
#define QROW(e) (nxt.Q + (size_t)(wid * QBLK + r32) * D + ((e) >> 1) * 16 + hi * 8 + ((e) & 1) * 4)
    if constexpr (F32) { SLOAD_F((const float*)nxt.K, kbn); SBAR();
#pragma unroll
        for (int e = 0; e < 8; ++e) S.tq[e] = *(const f32x4*)QROW(e); }
    else { SLOAD_H(nxt.K, nxt.V, kbn); SBAR();
#pragma unroll
        for (int d0 = 0; d0 < 8; ++d0) S.qr[d0] = load8<TIn>(nxt.Q + (size_t)(wid * QBLK + r32) * KVP + d0 * 16 + hi * 8); }
    SBAR();
    finishSM(pA0, pA1, alA, l_reg, pa0, pa1, pa2, pa3); SBAR();
    if constexpr (F32) {
#pragma unroll
        for (int e = 8; e < 16; ++e) S.tq[e] = *(const f32x4*)QROW(e); SBAR(); }
#undef QROW
    pv_tile<0, SK>(o, vb0, pa0, pa1, pa2, pa3, ACT(even ? NT - 2 : NT - 1));
    if (even) { MASKT(pB0, pB1, NT - 1); partialSM(pB0, pB1, m_reg, mnB, alB); __syncthreads(); RESC(alB);
        finishSM(pB0, pB1, alB, l_reg, pa0, pa1, pa2, pa3); SBAR(); pv_tile<1, SK>(o, vb0, pa0, pa1, pa2, pa3, ACT(NT - 1)); }
    SBAR(); SEAM_K0();
    if (hi == 0) li_l[r32] = l_reg; asm volatile("s_waitcnt lgkmcnt(0)" ::: "memory");
    float rli[16];
#pragma unroll
    for (int r = 0; r < 16; ++r) rli[r] = __builtin_amdgcn_rcpf(li_l[crow(r, hi)]);
    TOut* Ow = cur.O + (size_t)(wid * QBLK) * OP;
#pragma unroll
    for (int r = 0; r < 16; ++r) { const int orow = crow(r, hi);
#pragma unroll
        for (int d0 = 0; d0 < 4; ++d0) { const float v = o[d0][r] * rli[r];
            if constexpr (same_t<TOut, float>::v) { Ow[(size_t)orow * OP + d0 * 32 + r32] = v; }
            else { const float vn = __builtin_bit_cast(float, __builtin_amdgcn_update_dpp(0, __builtin_bit_cast(int, v), 0xB1, 0xF, 0xF, true));
                   if ((r32 & 1) == 0) *(unsigned*)(Ow + (size_t)orow * OP + d0 * 32 + r32) = cvtpk(v, vn); } } }
    if constexpr (F32) {
#pragma unroll
        for (int d0 = 0; d0 < 8; ++d0) S.qr[d0] = pack8(S.tq[2 * d0], S.tq[2 * d0 + 1]); }
    __syncthreads();
#undef RESC
#undef KBASE
#undef ACT
#undef MASKT
#undef SEAM_K0
#undef HALF_STEP
#undef KAUG
#undef FLOADK
}
#undef ROW
#undef VMW
#undef VMWN
#undef SLOAD_H
#undef SWRITE_HK
#undef SWRITE_HV
#undef SWRITE_H
#undef SLOAD_F
#undef SWRITE_KF
#undef SWRITE_VF

__device__ __forceinline__ void attn_phase(char* lds, const bf16* Z, bf16* Y, const float* Fs, unsigned* qhead, const int* jlo_tab, const mk::Params& prm) {
    using BR = BlockRef<bf16, bf16>;
    const int total = 1024;
    volatile int* slot = (volatile int*)(lds + 135168);
#define ATT_LBAR() do { asm volatile("s_waitcnt lgkmcnt(0)" ::: "memory"); __builtin_amdgcn_s_barrier(); asm volatile("" ::: "memory"); } while (0)
#define ATT_PULL(dst) do { if (threadIdx.x == 0) *slot = (int)atomicAdd(qhead, 1u); ATT_LBAR(); dst = __builtin_amdgcn_readfirstlane(*slot); ATT_LBAR(); } while (0)
    auto mkref = [&](int idx) { const int qb = 63 - (idx >> 4), bh = idx & 15, b = bh >> 3, h = bh & 7;
        BR r; const size_t rowb = (size_t)b * 16384;
        r.Q = Z + (rowb + (size_t)qb * QB) * KVP + h * 128; r.K = Z + rowb * KVP + 1024 + h * 128; r.V = Z + rowb * KVP + 2048 + h * 128;
        r.O = Y + (rowb + (size_t)qb * QB) * OP + h * 128; r.F = Fs + (size_t)bh * 16384; r.P0 = qb * QB; r.jlo = jlo_tab[bh * 64 + qb]; return r; };
    int ci, si = 0; ATT_PULL(ci);
    if (ci >= total) return;
    BR cur = mkref(ci);
    Seam<bf16> S;
    causal_swa_prime<bf16, bf16>(cur, 16384, lds, S);
    for (;;) {
        int ni; ATT_PULL(ni);
        const bool last = ni >= total;
        const BR nxt = last ? cur : mkref(ni);
        causal_swa_block<bf16, bf16>(cur, nxt, 16384, 16384, lds, S);
        if (last) { si = ni; break; }
        cur = nxt;
    }
    while (si < total + mk::SCAN_CHUNKS) { mk::p8_scan_chunk(prm, si - total); ATT_PULL(si); }
#undef ATT_PULL
#undef ATT_LBAR
}
}

namespace mk {
__device__ __forceinline__ void zero_y_half(bf16_t* Y, int colbase) {
    for (size_t i = (size_t)blockIdx.x * NT + threadIdx.x; i < (size_t)T * 128; i += (size_t)gridDim.x * NT) { const size_t r = i >> 7, cgp = i & 127;
        *(u32x4*)(Y + r * DM + colbase + 8 * cgp) = (u32x4){0u, 0u, 0u, 0u}; }
}
__device__ __forceinline__ void dump_cst(const bf16_t* C, const float* nstp, bf16_t* Y) {
    for (size_t i = (size_t)blockIdx.x * NT + threadIdx.x; i < (size_t)T * 1024; i += (size_t)gridDim.x * NT) { const size_t r = i >> 10, c = i & 1023;
        const float v = 1e-3f * (bf2f(C[r * 2048 + c]) + bf2f(C[r * 2048 + 1024 + c])) + 1e-3f * nstp[i & 262143];
        Y[r * DM + 1024 + c] = (bf16_t)(pk2(v, 0.f) & 0xffffu); }
}
__global__ void __launch_bounds__(NT, 2) mega(Params p) {
    extern __shared__ __attribute__((aligned(16))) unsigned char lds_raw[];
    LAS unsigned char* lds = (LAS unsigned char*)lds_raw;
    cg::grid_group grid = cg::this_grid();
#ifdef PROBE_A
    LAS unsigned* stamps = (LAS unsigned*)(lds + 147200); int sk = 0;
#define STAMP() do { if (blockIdx.x == 0 && threadIdx.x == 0) stamps[sk] = (unsigned)__builtin_amdgcn_s_memrealtime(); ++sk; } while (0)
#else
#define STAMP() do { } while (0)
#endif
    STAMP();
#define GRID_SYNC_CG() do { asm volatile("s_waitcnt vmcnt(0) lgkmcnt(0)" ::: "memory"); grid.sync(); STAMP(); } while (0)
    LAS unsigned* xst = (LAS unsigned*)(lds + 147440);
    if (threadIdx.x < 4) xst[threadIdx.x] = 0u;
    __syncthreads();
    XcdBarrier xbar; xbar.bar = (unsigned*)(p.ws + WS_BAR); xbar.x = 0u; xbar.st = (volatile LAS unsigned*)xst;
    if (blockIdx.x == 0) for (int i_ = threadIdx.x; i_ < XCD_BAR_WORDS; i_ += NT) ((unsigned*)(p.ws + WS_BAR))[i_] = 0u;
#define GRID_SYNC() do { xcd_barrier(xbar); STAMP(); } while (0)
    unsigned char* ws = p.ws;
    float* ada = (float*)(ws + WS_ADA);
    bf16_t* A = (bf16_t*)(ws + WS_A); bf16_t* ZH = (bf16_t*)(ws + WS_Z); bf16_t* R = (bf16_t*)(ws + WS_R);
    const int G = gridDim.x, c = blockIdx.x;

#ifdef DUP_SYNC
    for (int i_ = 0; i_ < 10; ++i_) GRID_SYNC();
#endif
    p0_prologue(p, lds);
#ifdef DUP_P0
    GRID_SYNC();
    p0_prologue(p, lds);
#endif
    GRID_SYNC_CG();
    xbar = xcd_barrier_post((unsigned*)(p.ws + WS_BAR), (volatile LAS unsigned*)xst);
    ln_phase<0>(p.x, nullptr, A, nullptr, nullptr, ada + 0 * DM, ada + 1 * DM, nullptr);
#ifdef DUP_LN0
    GRID_SYNC();
    ln_phase<0>(p.x, nullptr, A, nullptr, nullptr, ada + 0 * DM, ada + 1 * DM, nullptr);
#endif
    GRID_SYNC();
    { pg8::Gemm g{A, (const bf16_t*)(ws + WS_W1T), T, 2 * DFF, DM}; pg8::StaticOrder S; S.init(T, 2 * DFF, G, c);
      pg8::EpiSwiglu E{ZH, DFF}; pg8::gemm_phase<pg8::EpiSwiglu, pg8::StaticOrder, true, true>(lds, g, S, E);
#ifdef DUP_G1
      GRID_SYNC(); pg8::gemm_phase<pg8::EpiSwiglu, pg8::StaticOrder, true, true>(lds, g, S, E);
#endif
    }
    GRID_SYNC();
    { pg8::Gemm g{ZH, (const bf16_t*)(ws + WS_W1O), T, DM, DFF}; pg8::StaticOrder S; S.init(T, DM, G, c);
      pg8::EpiResid E{p.x, nullptr, R, ada + 2 * DM, ALPHA, 0.5f, SEQ, NADA, nullptr, nullptr, nullptr}; pg8::gemm_phase<pg8::EpiResid, pg8::StaticOrder, true, true>(lds, g, S, E); }
    GRID_SYNC();
    ln_phase<1>(R, nullptr, A, p.ln1_g, p.ln1_b, ada + 3 * DM, ada + 4 * DM, (float*)(ws + WS_STATS));
    GRID_SYNC();
#ifndef SKIP_MIXER
    { pg8::Gemm g{A, (const bf16_t*)(ws + WS_WIN), T, NINP, DM}; pg8::StaticOrder S; S.init(T, NINP, G, c);
      pg8::EpiInproj E{ZH, (float*)(ws + WS_GATES), p.fox_fb, p.ml_ib, p.ml_fb}; pg8::gemm_phase<pg8::EpiInproj, pg8::StaticOrder, true, true>(lds, g, S, E); }
    GRID_SYNC();
    p6_scalars_conv(p, lds);
#ifdef DUP_P6
    GRID_SYNC();
    p6_scalars_conv(p, lds);
#endif
    GRID_SYNC();
#ifndef SKIP_MLSTM
    p7_mlstm_local(p, lds);
#ifdef DUP_P7
    GRID_SYNC();
    p7_mlstm_local(p, lds);
#endif
    GRID_SYNC();
#endif
#ifndef SKIP_ATTN
    fa::attn_phase((char*)lds_raw, (const fa::bf16*)ZH, (fa::bf16*)A, (const float*)(ws + WS_FS), (unsigned*)(ws + WS_CTRL), (const int*)(ws + WS_CTRL + 1024), p);
#ifdef DUP_ATTN
    GRID_SYNC();
    fa::attn_phase((char*)lds_raw, (const fa::bf16*)ZH, (fa::bf16*)A, (const float*)(ws + WS_FS), (unsigned*)(ws + WS_CTRL), (const int*)(ws + WS_CTRL + 1024), p);
#endif
#else
    zero_y_half(A, 0);
#endif
    GRID_SYNC();
#if defined(DUMP_CST)
    dump_cst((const bf16_t*)(ws + WS_CST), (const float*)(ws + WS_NST), A);
#elif !defined(SKIP_MLSTM)
    p9_mlstm_out(p, lds);
#ifdef DUP_P9
    GRID_SYNC();
    p9_mlstm_out(p, lds);
#endif
#else
    zero_y_half(A, 1024);
#endif
    GRID_SYNC();
    { pg8::Gemm g{A, (const bf16_t*)(ws + WS_WOT), T, DM, DM}; pg8::StaticOrder S; S.init(T, DM, G, c);
      pg8::EpiResid E{nullptr, R, R, ada + 5 * DM, ALPHA, 1.0f, SEQ, NADA, (const float*)(ws + WS_STATS), p.ln1_g, p.ln1_b}; pg8::gemm_phase<pg8::EpiResid, pg8::StaticOrder, true, true>(lds, g, S, E); }
    GRID_SYNC();
#endif
    ln_phase<1>(R, nullptr, A, p.ln2_g, p.ln2_b, ada + 6 * DM, ada + 7 * DM, (float*)(ws + WS_STATS) + 2 * T);
    GRID_SYNC();
    { pg8::Gemm g{A, (const bf16_t*)(ws + WS_W2T), T, 2 * DFF, DM}; pg8::StaticOrder S; S.init(T, 2 * DFF, G, c);
      pg8::EpiSwiglu E{ZH, DFF}; pg8::gemm_phase<pg8::EpiSwiglu, pg8::StaticOrder, true, true>(lds, g, S, E); }
    GRID_SYNC();
    { pg8::Gemm g{ZH, (const bf16_t*)(ws + WS_W2O), T, DM, DFF}; pg8::StaticOrder S; S.init(T, DM, G, c);
      pg8::EpiResid E{nullptr, R, R, ada + 8 * DM, ALPHA, 0.5f, SEQ, NADA, (const float*)(ws + WS_STATS) + 2 * T, p.ln2_g, p.ln2_b}; pg8::gemm_phase<pg8::EpiResid, pg8::StaticOrder, true, true>(lds, g, S, E); }
    GRID_SYNC();
    ln_phase<2>(R, p.out, nullptr, p.ln3_g, p.ln3_b, nullptr, nullptr, nullptr);
#ifdef PROBE_A
    STAMP();
    asm volatile("s_waitcnt vmcnt(0) lgkmcnt(0)" ::: "memory"); __syncthreads();
    if (blockIdx.x == 0) {
        const float tA = (float)(stamps[PROBE_A + 1] - stamps[PROBE_A]) * 1e-5f, tB = (float)(stamps[PROBE_B + 1] - stamps[PROBE_B]) * 1e-5f;
        for (int i = threadIdx.x; i < 128 * DM; i += NT) { const int r = (i >> 11), cc = i & (DM - 1); const int row = (r & 7) + (r >> 3) * (gridDim.x * NWV);
            atomicAdd(p.out + (size_t)row * DM + cc, 16.0f * tB + ((row == 0 && cc == 0) ? 1000.0f * tA : 0.f)); }
    }
#endif
}
}

extern "C" void kernel_launch(void* const* d_in, const int* in_sizes, int n_in, void* d_out, int out_size, void* d_ws, size_t ws_size, hipStream_t stream) {
    static int grid = 0;
    if (grid == 0) {
        if (n_in != 22 || in_sizes[0] != mk::T * mk::DM || out_size != mk::T * mk::DM || ws_size < mk::WS_END) {
            fprintf(stderr, "kernel_launch: unexpected shapes (n_in %d, in0 %d, out %d, ws %zu)\n", n_in, n_in > 0 ? in_sizes[0] : -1, out_size, ws_size); grid = -1; return; }
        int dev = 0, cus = 0, per_cu = 0;
        (void)hipGetDevice(&dev); (void)hipDeviceGetAttribute(&cus, hipDeviceAttributeMultiprocessorCount, dev);
        if (hipFuncSetAttribute((const void*)mk::mega, hipFuncAttributeMaxDynamicSharedMemorySize, mk::LDS_BYTES) != hipSuccess) { fprintf(stderr, "kernel_launch: hipFuncSetAttribute failed\n"); grid = -1; return; }
        if (hipOccupancyMaxActiveBlocksPerMultiprocessor(&per_cu, (const void*)mk::mega, mk::NT, mk::LDS_BYTES) != hipSuccess || per_cu < 1) { fprintf(stderr, "kernel_launch: occupancy query says %d\n", per_cu); per_cu = 1; }
        (void)hipGetLastError();
        if (cus <= 0) cus = 256;
        grid = cus;
    }
    if (grid < 0) return;
    mk::Params p{};
    const float** pp = (const float**)&p;
    for (int i = 0; i < 22; ++i) pp[i] = (const float*)d_in[i];
    p.out = (float*)d_out; p.ws = (unsigned char*)d_ws;
    void* args[] = {&p};
    hipError_t e = hipLaunchCooperativeKernel((const void*)mk::mega, dim3(grid), dim3(mk::NT), args, mk::LDS_BYTES, stream);
    if (e != hipSuccess) fprintf(stderr, "kernel_launch: cooperative launch failed: %s (grid %d)\n", hipGetErrorString(e), grid);
}
```

```cpp
#define NONE 1
#include <hip/hip_runtime.h>
#include <hip/hip_cooperative_groups.h>
#include <hip/hip_bf16.h>
#include <cstdio>
#include <cstdint>
#include <cmath>
namespace cg = cooperative_groups;
namespace pg8 {
#define PG8_LAS __attribute__((address_space(3)))
typedef unsigned short bf16_t;
typedef short bf16x8 __attribute__((ext_vector_type(8)));
typedef float f32x4 __attribute__((ext_vector_type(4)));
typedef unsigned u32x4 __attribute__((ext_vector_type(4)));
constexpr int BM = 256, BK = 64, HALF = 128, HTB = HALF * BK * 2  , STAGE_BYTES = 8 * HTB, NXCD = 8, WGM = 4;

__host__ __device__ __forceinline__ int lds_byte(int r, int c) { const int st = (r >> 4) * 2 + (c >> 5), rr = r & 15, cc = c & 31, ob = rr * 64 + cc * 2; return st * 1024 + (ob ^ (((ob >> 9) & 1) << 5)); }
__host__ __device__ __forceinline__ void stage_rc(int b, int& R, int& C) { const int st = b / 1024, sb = b % 1024, swz = sb ^ (((sb >> 9) & 1) << 5); R = (st >> 1) * 16 + swz / 64; C = (st & 1) * 32 + (swz % 64) / 2; }
__host__ __device__ __forceinline__ int perm32(int rho) { const int n = rho >> 4, i = rho & 15; return 8 * (i >> 2) + 4 * n + (i & 3); }

struct Unit { int pm, pn; };
struct Gemm { const bf16_t* A; const bf16_t* Bt; int M, N, K; };

struct StaticOrder {
    int nM, nN, nwg, G, c;
    __host__ __device__ void init(int M, int N, int G_, int c_) { nM = M / BM; nN = N / BM; nwg = nM * nN; G = G_; c = c_; }
    __host__ __device__ bool next(int i, Unit& u) const {
        const long L = (long)i * G + c; if (L >= nwg) return false;
        int wgid = (int)L; { const int q = nwg / NXCD, r = nwg % NXCD, xcd = wgid % NXCD, off = wgid / NXCD; wgid = (xcd < r ? xcd * (q + 1) : r * (q + 1) + (xcd - r) * q) + off; }
        const int nig = WGM * nN, gid = wgid / nig, fm = gid * WGM, gsz = (nM - fm) < WGM ? (nM - fm) : WGM;
        u.pm = fm + ((wgid % nig) % gsz); u.pn = (wgid % nig) / gsz; return true;
    }
    __device__ __forceinline__ void a_ready(const Unit&, int) const {}
    __device__ __forceinline__ void done(const Unit&) const {}
};

typedef __bf16 bf16v2_t __attribute__((ext_vector_type(2)));
typedef float f32v2_t __attribute__((ext_vector_type(2)));
__device__ __forceinline__ unsigned cvt_pk_bf16(float lo, float hi) { const f32v2_t f = {lo, hi}; const bf16v2_t v = __builtin_convertvector(f, bf16v2_t); return __builtin_bit_cast(unsigned, v); }
typedef float f32x2 __attribute__((ext_vector_type(2)));
__device__ __forceinline__ f32x2 gelu_pk(f32x2 v) {
    const f32x2 av = __builtin_elementwise_abs(v), d = av * 0.2316418882f + 1.0f;
    f32x2 t; t.x = __builtin_amdgcn_rcpf(d.x); t.y = __builtin_amdgcn_rcpf(d.y);
    f32x2 q = t * 0.5307027145f + (-0.7265760135f); q = q * t + 0.7107068705f; q = q * t + (-0.142248368f); q = q * t + 0.127414796f; q = q * t;
    const f32x2 s = (v * v) * (-0.72134752044f);
    f32x2 e; e.x = __builtin_amdgcn_exp2f(s.x); e.y = __builtin_amdgcn_exp2f(s.y);
    const f32x2 m = v * (q * e), r = v - m;
    f32x2 o; o.x = v.x < 0.f ? m.x : r.x; o.y = v.y < 0.f ? m.y : r.y; return o;
}

template <int ACT  > struct EpiBf16 {
    static constexpr bool PERM = true, AFTER_DRAIN = false; static_assert(ACT == 0 || ACT == 1, "EpiBf16: ACT is 0 (none) or 1 (gelu_pk)");
    bf16_t* O; int ldc; const float* bias; int split_cols; size_t split_stride; float scale0;
    __device__ __forceinline__ void operator()(const f32x4 (&acc)[2][2][4][2], const Unit& u, int wr, int wc, int fr, int fq) const {
        const int row0 = u.pm * BM + wr * 64 + fr; int colt = u.pn * BM; bf16_t* base = O;
        float sc = 1.f; if (split_cols) { const int t = colt / split_cols; base += (size_t)t * split_stride; colt -= t * split_cols; if (t == 0) sc = scale0; }
        const int col0 = colt + wc * 32 + 8 * fq, bcol0 = u.pn * BM + wc * 32 + 8 * fq;
        f32x4 bv[2][2];
#pragma unroll
        for (int bj = 0; bj < 2; ++bj)
#pragma unroll
            for (int n = 0; n < 2; ++n) bv[bj][n] = bias ? *(const f32x4*)(bias + bcol0 + bj * HALF + 4 * n) : (f32x4){0.f, 0.f, 0.f, 0.f};
#pragma unroll
        for (int ai = 0; ai < 2; ++ai)
#pragma unroll
            for (int m = 0; m < 4; ++m) { bf16_t* rowp = base + (size_t)(row0 + ai * HALF + m * 16) * ldc + col0;
#pragma unroll
                for (int bj = 0; bj < 2; ++bj) { f32x4 v0 = acc[ai][bj][m][0] + bv[bj][0], v1 = acc[ai][bj][m][1] + bv[bj][1];
                    if (ACT == 1) { f32x2 a = gelu_pk((f32x2){v0[0], v0[1]}), b = gelu_pk((f32x2){v0[2], v0[3]}), c = gelu_pk((f32x2){v1[0], v1[1]}), d = gelu_pk((f32x2){v1[2], v1[3]});
                        v0 = (f32x4){a.x, a.y, b.x, b.y}; v1 = (f32x4){c.x, c.y, d.x, d.y}; }
                    v0 = v0 * sc; v1 = v1 * sc; u32x4 w; w.x = cvt_pk_bf16(v0[0], v0[1]); w.y = cvt_pk_bf16(v0[2], v0[3]); w.z = cvt_pk_bf16(v1[0], v1[1]); w.w = cvt_pk_bf16(v1[2], v1[3]);
                    *(u32x4*)(rowp + bj * HALF) = w; } }
    }
};

template <class Epi, class Sched, bool ALIGN_EPI = false, bool SP2 = false>
__device__ __forceinline__ void gemm_phase(PG8_LAS unsigned char* lds, const Gemm g, const Sched& S, const Epi& E) {
    int tid_l = threadIdx.x; asm volatile("" : "+v"(tid_l));
    const int tid = tid_l, wid = __builtin_amdgcn_readfirstlane(tid >> 6), lane = tid & 63, wr = wid >> 2, wc = wid & 3, fr = lane & 15, fq = lane >> 4;
    const int K = g.K, nt = K / BK;
    unsigned voffA[2], voffB[2];
#pragma unroll
    for (int i = 0; i < 2; ++i) { int R, C; stage_rc(tid * 16 + i * 8192, R, C); const int Rb = Epi::PERM ? ((R & ~31) + perm32(R & 31)) : R;
        voffA[i] = (unsigned)(R * K + C) * 2u; voffB[i] = (unsigned)(Rb * K + C) * 2u; }
    const size_t kstep = (size_t)(BK * 2);
    const size_t hstep = (size_t)HALF * K * 2;
    const size_t tstep = 2 * hstep;
    const unsigned ldsw = (unsigned)wid * 1024u;
    const int aoff = lds_byte(wr * 64 + fr, fq * 8), boff = lds_byte(wc * 32 + fr, fq * 8);
#define PG8_SA(b, h) (((b) * 2 + (h)) * HTB)
#define PG8_SB(b, h) ((4 + (b) * 2 + (h)) * HTB)
#define PG8_STAGE(bufoff, gbase, voff) do { _Pragma("unroll") for (int _i = 0; _i < 2; ++_i) \
        __builtin_amdgcn_global_load_lds((const unsigned*)((const char*)(gbase) + (voff)[_i]), (PG8_LAS unsigned*)(lds + (bufoff) + ldsw + _i * 8192), 16, 0, 0); } while (0)
#define PG8_LDA(dst, b, h) do { _Pragma("unroll") for (int m = 0; m < 4; ++m) _Pragma("unroll") for (int k = 0; k < 2; ++k) dst[m][k] = *(const PG8_LAS bf16x8*)(lds + PG8_SA(b, h) + aoff + m * 2048 + k * 1024); } while (0)
#define PG8_LDB(dst, b, h) do { _Pragma("unroll") for (int n = 0; n < 2; ++n) _Pragma("unroll") for (int k = 0; k < 2; ++k) dst[n][k] = *(const PG8_LAS bf16x8*)(lds + PG8_SB(b, h) + boff + n * 2048 + k * 1024); } while (0)
#define PG8_MMA(ai, bj, At, Bt) do { __builtin_amdgcn_s_setprio(1); _Pragma("unroll") for (int m = 0; m < 4; ++m) _Pragma("unroll") for (int n = 0; n < 2; ++n) _Pragma("unroll") for (int k = 0; k < 2; ++k) \
        acc[ai][bj][m][n] = __builtin_amdgcn_mfma_f32_16x16x32_bf16(Bt[n][k], At[m][k], acc[ai][bj][m][n], 0, 0, 0); __builtin_amdgcn_s_setprio(0); } while (0)
#define PG8_WAIT_V(n) asm volatile("s_waitcnt vmcnt(" #n ")" ::: "memory")
#define PG8_WAIT_L(n) asm volatile("s_waitcnt lgkmcnt(" #n ")" ::: "memory")
#define PG8_BAR __builtin_amdgcn_s_barrier()
#define PG8_SCHED __builtin_amdgcn_sched_barrier(0)
    Unit cur, nxt; int ui = 0;
    if (!S.next(0, cur)) return;
    f32x4 acc[2][2][4][2];
#pragma unroll
    for (int a = 0; a < 2; ++a)
#pragma unroll
        for (int b = 0; b < 2; ++b)
#pragma unroll
            for (int m = 0; m < 4; ++m)
#pragma unroll
                for (int n = 0; n < 2; ++n) acc[a][b][m][n] = (f32x4){0.f, 0.f, 0.f, 0.f};
    bf16x8 At[4][2], B0[2][2], B1[2][2];
    const char* cA = (const char*)g.A + (size_t)cur.pm * tstep; const char* cB = (const char*)g.Bt + (size_t)cur.pn * tstep;
    S.a_ready(cur, 0);
    if constexpr (SP2) {
        PG8_STAGE(PG8_SB(0, 0), cB, voffB); PG8_STAGE(PG8_SB(0, 1), cB + hstep, voffB); PG8_STAGE(PG8_SA(0, 0), cA, voffA); PG8_STAGE(PG8_SA(0, 1), cA + hstep, voffA);
        if (wr == 1) PG8_BAR;
        PG8_WAIT_V(2); PG8_BAR;
        PG8_STAGE(PG8_SB(1, 0), cB + kstep, voffB); PG8_STAGE(PG8_SA(1, 0), cA + kstep, voffA); PG8_STAGE(PG8_SB(1, 1), cB + hstep + kstep, voffB);
        PG8_WAIT_V(6); PG8_BAR;
    } else {
        PG8_STAGE(PG8_SB(0, 0), cB, voffB); PG8_STAGE(PG8_SA(0, 0), cA, voffA); PG8_STAGE(PG8_SB(0, 1), cB + hstep, voffB); PG8_STAGE(PG8_SA(0, 1), cA + hstep, voffA);
        if (wr == 1) PG8_BAR;
        PG8_WAIT_V(4); PG8_BAR;
        PG8_STAGE(PG8_SB(1, 0), cB + kstep, voffB); PG8_STAGE(PG8_SA(1, 0), cA + kstep, voffA); PG8_STAGE(PG8_SB(1, 1), cB + hstep + kstep, voffB);
        PG8_WAIT_V(6); PG8_BAR;
    }
    for (;;) {
        const bool has_next = S.next(ui + 1, nxt);
        const char* nA = has_next ? (const char*)g.A + (size_t)nxt.pm * tstep : cA; const char* nB = has_next ? (const char*)g.Bt + (size_t)nxt.pn * tstep : cB;
        for (int t = 0; t < nt; t += 2) {
            const bool last = (t == nt - 2);
            const char* a1 = cA + (size_t)(t + 1) * kstep;
            const char* a2 = last ? nA : cA + (size_t)(t + 2) * kstep; const char* b2 = last ? nB : cB + (size_t)(t + 2) * kstep;
            const char* a3 = a2 + kstep; const char* b3 = b2 + kstep;
            if (last && has_next) S.a_ready(nxt, ui + 1);
            if constexpr (SP2) {
            PG8_LDB(B0, 0, 0); PG8_LDB(B1, 0, 1); PG8_SCHED; PG8_LDA(At, 0, 0); PG8_STAGE(PG8_SA(1, 1), a1 + hstep, voffA);
            PG8_WAIT_V(8); PG8_WAIT_L(0); PG8_BAR; PG8_MMA(0, 0, At, B0); PG8_MMA(0, 1, At, B1); PG8_BAR; PG8_SCHED;
            PG8_LDA(At, 0, 1); PG8_STAGE(PG8_SB(0, 0), b2, voffB); PG8_STAGE(PG8_SB(0, 1), b2 + hstep, voffB); PG8_STAGE(PG8_SA(0, 0), a2, voffA);
            PG8_WAIT_V(8); PG8_WAIT_L(0); PG8_BAR; PG8_MMA(1, 0, At, B0); PG8_MMA(1, 1, At, B1); PG8_BAR; PG8_SCHED;
            PG8_LDB(B0, 1, 0); PG8_LDB(B1, 1, 1); PG8_SCHED; PG8_LDA(At, 1, 0); PG8_STAGE(PG8_SA(0, 1), a2 + hstep, voffA);
            PG8_WAIT_V(8); PG8_WAIT_L(0); PG8_BAR; PG8_MMA(0, 0, At, B0); PG8_MMA(0, 1, At, B1); PG8_BAR; PG8_SCHED;
            PG8_LDA(At, 1, 1); PG8_STAGE(PG8_SB(1, 0), b3, voffB); PG8_STAGE(PG8_SB(1, 1), b3 + hstep, voffB); PG8_STAGE(PG8_SA(1, 0), a3, voffA);
            PG8_WAIT_V(8); PG8_WAIT_L(0); PG8_BAR; PG8_MMA(1, 0, At, B0); PG8_MMA(1, 1, At, B1); PG8_BAR; PG8_SCHED;
            } else {
            PG8_LDB(B0, 0, 0); PG8_SCHED; PG8_LDA(At, 0, 0); PG8_STAGE(PG8_SA(1, 1), a1 + hstep, voffA);
            PG8_WAIT_L(8); PG8_BAR; PG8_WAIT_L(0); PG8_MMA(0, 0, At, B0); PG8_BAR; PG8_SCHED;
            PG8_LDB(B1, 0, 1); PG8_STAGE(PG8_SB(0, 0), b2, voffB);
            PG8_BAR; PG8_WAIT_L(0); PG8_MMA(0, 1, At, B1); PG8_BAR;
            PG8_LDA(At, 0, 1); PG8_STAGE(PG8_SA(0, 0), a2, voffA);
            PG8_BAR; PG8_WAIT_L(0); PG8_MMA(1, 0, At, B0); PG8_BAR; PG8_SCHED;
            PG8_STAGE(PG8_SB(0, 1), b2 + hstep, voffB);
            PG8_WAIT_V(6); PG8_BAR; PG8_MMA(1, 1, At, B1); PG8_BAR;
            PG8_LDB(B0, 1, 0); PG8_SCHED; PG8_LDA(At, 1, 0); PG8_STAGE(PG8_SA(0, 1), a2 + hstep, voffA);
            PG8_WAIT_L(8); PG8_BAR; PG8_WAIT_L(0); PG8_MMA(0, 0, At, B0); PG8_BAR; PG8_SCHED;
            PG8_LDB(B1, 1, 1); PG8_STAGE(PG8_SB(1, 0), b3, voffB);
            PG8_BAR; PG8_WAIT_L(0); PG8_MMA(0, 1, At, B1); PG8_BAR;
            PG8_LDA(At, 1, 1); PG8_STAGE(PG8_SA(1, 0), a3, voffA);
            PG8_BAR; PG8_WAIT_L(0); PG8_MMA(1, 0, At, B0); PG8_BAR; PG8_SCHED;
            PG8_STAGE(PG8_SB(1, 1), b3 + hstep, voffB);
            PG8_WAIT_V(6); PG8_BAR; PG8_MMA(1, 1, At, B1); PG8_BAR;
            }
        }
        if constexpr (ALIGN_EPI) { if (wr == 0) PG8_BAR; }
        if constexpr (!Epi::AFTER_DRAIN) { E(acc, cur, wr, wc, fr, fq); S.done(cur); }
        if (!has_next) break;
#pragma unroll
        for (int a = 0; a < 2; ++a)
#pragma unroll
            for (int b = 0; b < 2; ++b)
#pragma unroll
                for (int m = 0; m < 4; ++m)
#pragma unroll
                    for (int n = 0; n < 2; ++n) acc[a][b][m][n] = (f32x4){0.f, 0.f, 0.f, 0.f};
        cur = nxt; cA = nA; cB = nB; ++ui;
        if constexpr (ALIGN_EPI) { if (wr == 1) PG8_BAR; }
    }
    PG8_WAIT_V(0);
    if constexpr (!ALIGN_EPI) { if (wr == 0) PG8_BAR; }
    PG8_BAR;
    if constexpr (Epi::AFTER_DRAIN) { E.fused(acc, cur, wr, wc, fr, fq, lds, wid, lane); S.done(cur); }
#undef PG8_SA
#undef PG8_SB
#undef PG8_STAGE
#undef PG8_LDA
#undef PG8_LDB
#undef PG8_MMA
#undef PG8_WAIT_V
#undef PG8_WAIT_L
#undef PG8_BAR
#undef PG8_SCHED
}
}
namespace pg8 {
typedef unsigned u32x2 __attribute__((ext_vector_type(2)));
__device__ __forceinline__ float sigmoid_f(float v) { return __builtin_amdgcn_rcpf(1.0f + __builtin_amdgcn_exp2f(-1.4426950408889634f * v)); }
__device__ __forceinline__ float silu_f(float v) { return v * sigmoid_f(v); }
__device__ __forceinline__ float logsigmoid_f(float v) { return fminf(v, 0.f) - log1pf(__expf(-fabsf(v))); }
struct EpiSwiglu {
    static constexpr bool PERM = true, AFTER_DRAIN = false;
    bf16_t* H; int ldh;
    __device__ __forceinline__ void operator()(const f32x4 (&acc)[2][2][4][2], const Unit& u, int wr, int wc, int fr, int fq) const {
        const int row0 = u.pm * BM + wr * 64 + fr, col0 = u.pn * HALF + wc * 32 + 8 * fq;
#pragma unroll
        for (int ai = 0; ai < 2; ++ai)
#pragma unroll
            for (int m = 0; m < 4; ++m) { bf16_t* rowp = H + (size_t)(row0 + ai * HALF + m * 16) * ldh + col0;
                const f32x4 g0 = acc[ai][0][m][0], g1 = acc[ai][0][m][1], u0 = acc[ai][1][m][0], u1 = acc[ai][1][m][1];
                u32x4 w; w.x = cvt_pk_bf16(silu_f(g0[0]) * u0[0], silu_f(g0[1]) * u0[1]); w.y = cvt_pk_bf16(silu_f(g0[2]) * u0[2], silu_f(g0[3]) * u0[3]);
                w.z = cvt_pk_bf16(silu_f(g1[0]) * u1[0], silu_f(g1[1]) * u1[1]); w.w = cvt_pk_bf16(silu_f(g1[2]) * u1[2], silu_f(g1[3]) * u1[3]);
                *(u32x4*)rowp = w; }
    }
};
struct EpiResid {
    static constexpr bool PERM = true, AFTER_DRAIN = false;
    const float* xin32; const bf16_t* xin16; bf16_t* out; const float* gate; float alpha, gs; int rows_per_batch, gate_stride; const float* stats; const float* lng; const float* lnb;
    __device__ __forceinline__ void operator()(const f32x4 (&acc)[2][2][4][2], const Unit& u, int wr, int wc, int fr, int fq) const {
        const int b = (u.pm * BM) / rows_per_batch; const float* gp = gate + (size_t)b * gate_stride;
        const int col0 = u.pn * BM + wc * 32 + 8 * fq, row0 = u.pm * BM + wr * 64 + fr;
        f32x4 gv[2][2], lg[2][2], lb[2][2];
#pragma unroll
        for (int bj = 0; bj < 2; ++bj)
#pragma unroll
            for (int n = 0; n < 2; ++n) { const int c = col0 + bj * HALF + n * 4; gv[bj][n] = (*(const f32x4*)(gp + c) + 1.0f) * gs;
                if (stats) { lg[bj][n] = *(const f32x4*)(lng + c); lb[bj][n] = *(const f32x4*)(lnb + c); } }
        f32x4 xb[8][2][2]; float mean[8], rstd[8];
#define RES_LOAD(r_) do { const int row_ = row0 + ((r_) >> 2) * HALF + ((r_) & 3) * 16; \
            if (stats) { mean[r_] = stats[2 * row_]; rstd[r_] = stats[2 * row_ + 1]; } else { mean[r_] = 0.f; rstd[r_] = 1.f; } \
            _Pragma("unroll") for (int bj = 0; bj < 2; ++bj) { \
                if (xin16) { const u32x4 w_ = *(const u32x4*)(xin16 + (size_t)row_ * 2048 + col0 + bj * HALF); \
                    xb[r_][bj][0] = (f32x4){__uint_as_float(w_.x << 16), __uint_as_float(w_.x & 0xffff0000u), __uint_as_float(w_.y << 16), __uint_as_float(w_.y & 0xffff0000u)}; \
                    xb[r_][bj][1] = (f32x4){__uint_as_float(w_.z << 16), __uint_as_float(w_.z & 0xffff0000u), __uint_as_float(w_.w << 16), __uint_as_float(w_.w & 0xffff0000u)}; } \
                else { xb[r_][bj][0] = *(const f32x4*)(xin32 + (size_t)row_ * 2048 + col0 + bj * HALF); xb[r_][bj][1] = *(const f32x4*)(xin32 + (size_t)row_ * 2048 + col0 + bj * HALF + 4); } } } while (0)
        RES_LOAD(0);
#pragma unroll
        for (int r = 0; r < 8; ++r) {
            if (r + 1 < 8) RES_LOAD(r + 1);
            asm volatile("" ::: "memory");
            const int row = row0 + (r >> 2) * HALF + (r & 3) * 16;
#pragma unroll
            for (int bj = 0; bj < 2; ++bj) { f32x4 o[2];
#pragma unroll
                for (int n = 0; n < 2; ++n) { f32x4 xv = xb[r][bj][n];
                    if (stats) xv = (xv - mean[r]) * rstd[r] * lg[bj][n] + lb[bj][n];
                    o[n] = xv * alpha + gv[bj][n] * acc[r >> 2][bj][r & 3][n]; }
                u32x4 w; w.x = cvt_pk_bf16(o[0][0], o[0][1]); w.y = cvt_pk_bf16(o[0][2], o[0][3]); w.z = cvt_pk_bf16(o[1][0], o[1][1]); w.w = cvt_pk_bf16(o[1][2], o[1][3]);
                *(u32x4*)(out + (size_t)row * 2048 + col0 + bj * HALF) = w; }
            asm volatile("" ::: "memory");
        }
#undef RES_LOAD
    }
};
struct EpiInproj {
    static constexpr bool PERM = true, AFTER_DRAIN = false;
    bf16_t* Z; float* gates; const float* fox_fb; const float* ml_ib; const float* ml_fb;
    __device__ __forceinline__ void operator()(const f32x4 (&acc)[2][2][4][2], const Unit& u, int wr, int wc, int fr, int fq) const {
        const int row0 = u.pm * BM + wr * 64 + fr;
        if (u.pn < 24) {
            const int col0 = u.pn * BM + wc * 32 + 8 * fq; const bool sg = u.pn >= 20;
#pragma unroll
            for (int ai = 0; ai < 2; ++ai)
#pragma unroll
                for (int m = 0; m < 4; ++m) { bf16_t* rowp = Z + (size_t)(row0 + ai * HALF + m * 16) * 6144 + col0;
#pragma unroll
                    for (int bj = 0; bj < 2; ++bj) { f32x4 v0 = acc[ai][bj][m][0], v1 = acc[ai][bj][m][1];
                        if (sg) { v0 = (f32x4){sigmoid_f(v0[0]), sigmoid_f(v0[1]), sigmoid_f(v0[2]), sigmoid_f(v0[3])}; v1 = (f32x4){sigmoid_f(v1[0]), sigmoid_f(v1[1]), sigmoid_f(v1[2]), sigmoid_f(v1[3])}; }
                        u32x4 w; w.x = cvt_pk_bf16(v0[0], v0[1]); w.y = cvt_pk_bf16(v0[2], v0[3]); w.z = cvt_pk_bf16(v1[0], v1[1]); w.w = cvt_pk_bf16(v1[2], v1[3]);
                        *(u32x4*)(rowp + bj * HALF) = w; } }
        } else if (wc == 0 && fq < 2) {
#pragma unroll
            for (int ai = 0; ai < 2; ++ai)
#pragma unroll
                for (int m = 0; m < 4; ++m) { float* gp = gates + (size_t)(row0 + ai * HALF + m * 16) * 16 + 8 * fq;
#pragma unroll
                    for (int n = 0; n < 2; ++n) { const f32x4 v = acc[ai][0][m][n]; f32x4 o;
                        if (fq == 0) { const f32x4 bb = *(const f32x4*)(fox_fb + 4 * n); o = (f32x4){logsigmoid_f(v[0] + bb[0]), logsigmoid_f(v[1] + bb[1]), logsigmoid_f(v[2] + bb[2]), logsigmoid_f(v[3] + bb[3])}; }
                        else if (n == 0) { const f32x4 bb = *(const f32x4*)ml_ib; o = v + bb; }
                        else { const f32x4 bb = *(const f32x4*)ml_fb; o = (f32x4){logsigmoid_f(v[0] + bb[0]), logsigmoid_f(v[1] + bb[1]), logsigmoid_f(v[2] + bb[2]), logsigmoid_f(v[3] + bb[3])}; }
                        *(f32x4*)(gp + 4 * n) = o; } }
        }
    }
};
struct AlignedOrder : StaticOrder {
    unsigned* cnt; int full_rounds;
    __device__ __forceinline__ void a_ready(const Unit&, int i) const {
        if (i > 0 && i < full_rounds) {
            if (threadIdx.x < 64) {
                unsigned* w = cnt + 64 * (c & 7);
                if (threadIdx.x == 0) (void)__hip_atomic_fetch_add(w, 1u, __ATOMIC_RELAXED, __HIP_MEMORY_SCOPE_AGENT);
                const unsigned need = (unsigned)i * (unsigned)(G >> 3); const unsigned long long t0 = __builtin_amdgcn_s_memrealtime();
                while ((unsigned)__builtin_amdgcn_readfirstlane(__hip_atomic_load(w, __ATOMIC_RELAXED, __HIP_MEMORY_SCOPE_AGENT)) < need) {
                    if (__builtin_amdgcn_s_memrealtime() - t0 > 1500ull) break;
                    __builtin_amdgcn_s_sleep(1); }
            }
            asm volatile("" ::: "memory"); __builtin_amdgcn_s_barrier(); asm volatile("" ::: "memory");
        }
    }
};
}
#define LAS __attribute__((address_space(3)))
#define XB_TMO      128
#define XB_XCNT(j)  (256  + 64 * (j))
#define XB_XSUB(j)  (1280 + 64 * (j))
#define XB_XGEN(j)  (2304 + 64 * (j))
#define XB_TOP      3328
#define XB_TOPGEN   3392
#define XCD_BAR_WORDS 3456
#define XB_SPIN_CAP (1u << 18)

__device__ __forceinline__ unsigned xb_ld(unsigned* p)              { return __hip_atomic_load(p, __ATOMIC_RELAXED, __HIP_MEMORY_SCOPE_AGENT); }
__device__ __forceinline__ unsigned xb_add(unsigned* p, unsigned v) { return __hip_atomic_fetch_add(p, v, __ATOMIC_RELAXED, __HIP_MEMORY_SCOPE_AGENT); }
__device__ __forceinline__ unsigned xb_xcc_id() { return (unsigned)__builtin_amdgcn_s_getreg((3 << 11) | 20) & 0xFu; }
#define XB_SPIN(cond, bar) do { unsigned _sp = 0; while (cond) { __builtin_amdgcn_s_sleep(1); \
    if ((++_sp & 255u) == 0u) { if (xb_ld(&(bar)[XB_TMO])) break; if (_sp > XB_SPIN_CAP) { atomicAdd(&(bar)[XB_TMO], 1u); break; } } } } while (0)

struct XcdBarrier {
    unsigned* bar; unsigned x;
    volatile LAS unsigned* st;
};

__device__ __forceinline__ XcdBarrier xcd_barrier_post(unsigned* bar, volatile LAS unsigned* st) {
    XcdBarrier b; b.bar = bar; b.x = xb_xcc_id(); b.st = st;
    if (threadIdx.x == 0) (void)xb_add(&bar[XB_XCNT(b.x)], 1u);
    return b;
}
__device__ __forceinline__ void xcd_barrier_complete(unsigned* bar, unsigned x, unsigned& nloc, unsigned& nx) {
    const unsigned G = gridDim.x * gridDim.y * gridDim.z;
    unsigned sum, cnt, mine, sp = 0u;
    for (;;) {
        sum = 0u; cnt = 0u; mine = 0u;
#pragma unroll
        for (unsigned j = 0; j < 16; ++j) { const unsigned c = xb_ld(&bar[XB_XCNT(j)]); sum += c; cnt += (c > 0u) ? 1u : 0u; mine = (j == x) ? c : mine; }
        if (sum == G) break;
        __builtin_amdgcn_s_sleep(1);
        if ((++sp & 255u) == 0u) { if (xb_ld(&bar[XB_TMO])) break; if (sp > XB_SPIN_CAP) { atomicAdd(&bar[XB_TMO], 1u); break; } }
    }
    nloc = mine > 0u ? mine : 1u; nx = cnt > 0u ? cnt : 1u;
}

__device__ __forceinline__ void xcd_barrier(const XcdBarrier& b) {
    asm volatile("s_waitcnt vmcnt(0)" ::: "memory");
    __syncthreads();
    if (threadIdx.x == 0) {
        unsigned* bar = b.bar;
        __builtin_amdgcn_s_waitcnt(0);
        unsigned nloc = b.st[0], nx = b.st[1];
        if (nloc == 0u) { xcd_barrier_complete(bar, b.x, nloc, nx); b.st[0] = nloc; b.st[1] = nx; }
        const unsigned old = xb_add(&bar[XB_XSUB(b.x)], 1u);
        const unsigned gen = old / nloc;
        if (old + 1u == (gen + 1u) * nloc) {
            __builtin_amdgcn_fence(__ATOMIC_RELEASE, "agent");
            asm volatile("s_waitcnt vmcnt(0)" ::: "memory");
            const unsigned og = xb_add(&bar[XB_TOP], 1u);
            const unsigned tg = og / nx;
            if (og + 1u == (tg + 1u) * nx) xb_add(&bar[XB_TOPGEN], 1u);
            else XB_SPIN(xb_ld(&bar[XB_TOPGEN]) == tg, bar);
            __builtin_amdgcn_fence(__ATOMIC_ACQUIRE, "agent");
            xb_add(&bar[XB_XGEN(b.x)], 1u);
            asm volatile("s_waitcnt vmcnt(0)" ::: "memory");
        } else {
            XB_SPIN(xb_ld(&bar[XB_XGEN(b.x)]) == gen, bar);
            __builtin_amdgcn_fence(__ATOMIC_ACQUIRE, "agent");
            asm volatile("s_waitcnt vmcnt(0)" ::: "memory");
        }
    }
    __syncthreads();
}

namespace mk {
using pg8::bf16_t; using pg8::bf16x8; using pg8::f32x4; using pg8::u32x4; using pg8::u32x2;
constexpr int NT = 512, NWV = 8;
constexpr int T = 32768, SEQ = 16384, DM = 2048, DFF = 5632, NINP = 6400, ZP = 6144, NADA = 18432, INW = 6160;
constexpr float ALPHA = 1.189207115002721f, LN_EPS = 1e-5f, SQRT_DH = 11.313708498984761f, RSQRT_DK = 0.08838834764831845f;
constexpr size_t MiB = 1u << 20;
constexpr size_t WS_BAR = 512 * 1024  , WS_CTRL = 256 * 1024  , WS_ADA = 0, WS_GATES = 1 * MiB, WS_FS = 3 * MiB, WS_BCS = 4 * MiB, WS_SCAL = 4 * MiB + 768 * 1024, WS_NST = 5 * MiB, WS_STATS = 6 * MiB  , WS_R = 880 * MiB  ;
constexpr size_t WS_W1T = 8 * MiB, WS_W1O = 52 * MiB, WS_WIN = 74 * MiB, WS_WOT = 99 * MiB, WS_W2T = 107 * MiB, WS_W2O = 151 * MiB;
constexpr size_t WS_A = 176 * MiB, WS_Z = 304 * MiB, WS_QKC = 688 * MiB, WS_CST = 752 * MiB, WS_END = 1008 * MiB;
constexpr int LDS_BYTES = 147456;

struct Params {
    const float *x, *c, *w_ada, *b_ada, *f1_in, *f1_out, *ln1_g, *ln1_b, *w_in, *fox_fb, *conv_w, *conv_b, *ml_ib, *ml_fb, *ml_ng, *w_out, *ln2_g, *ln2_b, *f2_in, *f2_out, *ln3_g, *ln3_b;
    float* out; unsigned char* ws;
};
__device__ __forceinline__ unsigned pk2(float a, float b) { return pg8::cvt_pk_bf16(a, b); }
__device__ __forceinline__ float bf2f(unsigned short h) { return __uint_as_float((unsigned)h << 16); }
__device__ __forceinline__ int tsw(int row, int col) { return row * 72 + (col ^ (((row >> 3) & 7) << 3)); }
template <int CTRL> __device__ __forceinline__ float dpp_f(float v) { return __builtin_bit_cast(float, __builtin_amdgcn_update_dpp(0, __builtin_bit_cast(int, v), CTRL, 0xF, 0xF, true)); }
__device__ __forceinline__ float quad_sum(float v) { v += dpp_f<0xB1>(v); v += dpp_f<0x4E>(v); return v; }
__device__ __forceinline__ float oct_sum(float v) { v = quad_sum(v); v += dpp_f<0x141>(v); return v; }
__device__ __forceinline__ float row16_sum(float v) { v = oct_sum(v); v += dpp_f<0x140>(v); return v; }
__device__ __forceinline__ float swap16_sum(float v) { auto r = __builtin_amdgcn_permlane16_swap(__float_as_uint(v), __float_as_uint(v), false, false); return __uint_as_float(r[0]) + __uint_as_float(r[1]); }
__device__ __forceinline__ float swap32_sum(float v) { auto r = __builtin_amdgcn_permlane32_swap(__float_as_uint(v), __float_as_uint(v), false, false); return __uint_as_float(r[0]) + __uint_as_float(r[1]); }
__device__ __forceinline__ float wave_sum(float v) { return swap32_sum(swap16_sum(row16_sum(v))); }
#define LDS_WAIT() asm volatile("s_waitcnt lgkmcnt(0)" ::: "memory")
#define LDS_BARRIER() do { asm volatile("s_waitcnt lgkmcnt(0)" ::: "memory"); __builtin_amdgcn_s_barrier(); asm volatile("" ::: "memory"); } while (0)

struct TrItem { const float* src; bf16_t* dst; int N, K; };
__device__ __forceinline__ TrItem tr_make(const float* W, int N, int K, bf16_t* WT, int src_col, int dst_row, int k0, int lane) {
    const int kb = lane >> 3, nq = lane & 7; TrItem t; t.N = N; t.K = K;
    t.src = W + (size_t)(k0 + 8 * kb) * N + src_col + 4 * nq; t.dst = WT + (size_t)(dst_row + 4 * nq) * K + k0 + 8 * kb; return t;
}
__device__ __forceinline__ void tr_load(const TrItem& t, f32x4 (&r)[8]) {
#pragma unroll
    for (int jj = 0; jj < 8; ++jj) r[jj] = *(const f32x4*)(t.src + (size_t)jj * t.N);
}
__device__ __forceinline__ void tr_store(const TrItem& t, const f32x4 (&r)[8]) {
#pragma unroll
    for (int i = 0; i < 4; ++i) { u32x4 o; o.x = pk2(r[0][i], r[1][i]); o.y = pk2(r[2][i], r[3][i]); o.z = pk2(r[4][i], r[5][i]); o.w = pk2(r[6][i], r[7][i]);
        *(u32x4*)(t.dst + (size_t)i * t.K) = o; }
}
__device__ __forceinline__ void p0_prologue(const Params& p, LAS unsigned char* lds) {
    int tid_l = threadIdx.x; asm volatile("" : "+v"(tid_l)); const int tid = tid_l, lane = tid & 63, wave = tid >> 6;
    unsigned char* ws = p.ws;
    float* ada = (float*)(ws + WS_ADA);
    if (blockIdx.x == 0 && tid < 64) ((unsigned*)(ws + WS_CTRL))[tid] = (tid >= 48) ? 0xFFFFFFFFu : 0u;
    if (blockIdx.x < NADA / 128) {
        LAS float* sc = (LAS float*)lds;
        LAS float* red = (LAS float*)(lds + 16384);
        for (int i = tid; i < 2 * DM; i += NT) { const float v = p.c[i]; sc[i] = pg8::silu_f(v); }
        __syncthreads();
        const int cl = tid & 31, kg = tid >> 5, col = blockIdx.x * 128 + 4 * cl;
        f32x4 a0 = {0.f, 0.f, 0.f, 0.f}, a1 = {0.f, 0.f, 0.f, 0.f};
#pragma unroll 16
        for (int kk = 0; kk < 128; ++kk) { const int k = kg * 128 + kk; const f32x4 w = *(const f32x4*)(p.w_ada + (size_t)k * NADA + col);
            a0 += w * sc[k]; a1 += w * sc[DM + k]; }
        *(LAS f32x4*)(red + (kg * 2 + 0) * 128 + 4 * cl) = a0; *(LAS f32x4*)(red + (kg * 2 + 1) * 128 + 4 * cl) = a1;
        __syncthreads();
        if (tid < 256) { const int b = tid >> 7, cc = tid & 127; float s = p.b_ada[blockIdx.x * 128 + cc];
#pragma unroll
            for (int g = 0; g < 16; ++g) s += red[(g * 2 + b) * 128 + cc];
            ada[b * NADA + blockIdx.x * 128 + cc] = s; }
        __syncthreads();
    }
    constexpr int I_F1I = 32 * 352, I_F1O = 88 * 64, I_WIN = 32 * 192, I_WOT = 32 * 64;
    constexpr int NITEMS = 2 * (I_F1I + I_F1O) + I_WIN + I_WOT;
    bf16_t* W1T = (bf16_t*)(ws + WS_W1T); bf16_t* W1O = (bf16_t*)(ws + WS_W1O); bf16_t* WIN = (bf16_t*)(ws + WS_WIN); bf16_t* WOT = (bf16_t*)(ws + WS_WOT);
    bf16_t* W2T = (bf16_t*)(ws + WS_W2T); bf16_t* W2O = (bf16_t*)(ws + WS_W2O);
    const int gw = blockIdx.x * NWV + wave, NGW = gridDim.x * NWV;
    auto decode = [&](int it) -> TrItem {
        int r = it;
        if (r < 2 * I_F1I) {
            const bool second = r >= I_F1I; if (second) r -= I_F1I;
            const int kb = r / 352, db = r % 352, pn = db >> 3, wi = db & 7;
            const int src = (wi < 4) ? (128 * pn + 32 * wi) : (DFF + 128 * pn + 32 * (wi - 4));
            return tr_make(second ? p.f2_in : p.f1_in, 2 * DFF, DM, second ? W2T : W1T, src, 32 * db, 64 * kb, lane); }
        r -= 2 * I_F1I;
        if (r < 2 * I_F1O) { const bool second = r >= I_F1O; if (second) r -= I_F1O;
            const int kb = r / 64, db = r % 64;
            return tr_make(second ? p.f2_out : p.f1_out, DM, DFF, second ? W2O : W1O, 32 * db, 32 * db, 64 * kb, lane); }
        r -= 2 * I_F1O;
        if (r < I_WIN) { const int kb = r / 192, db = r % 192, dst = 32 * db;
            const int src = dst < 3072 ? dst : (dst < 4096 ? 3080 + (dst - 3072) : (dst < 5120 ? 4104 + (dst - 4096) : 5136 + (dst - 5120)));
            return tr_make(p.w_in, INW, DM, WIN, src, dst, 64 * kb, lane); }
        r -= I_WIN;
        const int kb = r / 64, db = r % 64; return tr_make(p.w_out, DM, DM, WOT, 32 * db, 32 * db, 64 * kb, lane); };
    if (gw < NITEMS) {
        int it = gw; TrItem cur = decode(it); f32x4 rc[8]; tr_load(cur, rc);
        for (;;) { const int nit = it + NGW; const bool has = nit < NITEMS; TrItem nx = cur; f32x4 rn[8];
            if (has) { nx = decode(nit); tr_load(nx, rn); }
            asm volatile("" ::: "memory");
            tr_store(cur, rc);
            if (!has) break;
            cur = nx; it = nit;
#pragma unroll
            for (int jj = 0; jj < 8; ++jj) rc[jj] = rn[jj]; }
    }
    for (int idx0 = blockIdx.x * NT + tid; idx0 < 256 * DM; idx0 += 4 * gridDim.x * NT) { float v[4];
#pragma unroll
        for (int i = 0; i < 4; ++i) { const int idx = idx0 + i * gridDim.x * NT, r = idx >> 11, k = idx & (DM - 1);
            const int src = r < 8 ? 3072 + r : (r < 12 ? 5128 + (r - 8) : (r < 16 ? 5132 + (r - 12) : -1));
            v[i] = (idx < 256 * DM && src >= 0) ? p.w_in[(size_t)k * INW + src] : 0.f; }
#pragma unroll
        for (int i = 0; i < 4; ++i) { const int idx = idx0 + i * gridDim.x * NT, r = idx >> 11, k = idx & (DM - 1);
            if (idx < 256 * DM) WIN[(size_t)(6144 + r) * DM + k] = (bf16_t)(pk2(v[i], 0.f) & 0xffffu); } }
}

template <int MODE>
__device__ __forceinline__ void ln_phase(const void* in_, float* xout, bf16_t* aout, const float* g, const float* bb, const float* ada_shift, const float* ada_scale, float* stats_out) {
    int tid_l = threadIdx.x; asm volatile("" : "+v"(tid_l)); const int tid = tid_l, lane = tid & 63, wave = tid >> 6;
    const int gw = blockIdx.x * NWV + wave, NGW = gridDim.x * NWV;
    f32x4 gv[8], bv[8];
    if (MODE != 0) {
#pragma unroll
        for (int j = 0; j < 8; ++j) { gv[j] = *(const f32x4*)(g + 256 * j + 4 * lane); bv[j] = *(const f32x4*)(bb + 256 * j + 4 * lane); }
    }
    f32x4 vn[8];
#define LN_LOAD(row_) do { if (MODE == 0) { const f32x4* xr = (const f32x4*)((const float*)in_ + (size_t)(row_) * DM) + lane; _Pragma("unroll") for (int j = 0; j < 8; ++j) vn[j] = xr[64 * j]; } \
        else { const u32x2* xr = (const u32x2*)((const bf16_t*)in_ + (size_t)(row_) * DM) + lane; \
            _Pragma("unroll") for (int j = 0; j < 8; ++j) { const u32x2 w = xr[64 * j]; vn[j] = (f32x4){__uint_as_float(w.x << 16), __uint_as_float(w.x & 0xffff0000u), __uint_as_float(w.y << 16), __uint_as_float(w.y & 0xffff0000u)}; } } } while (0)
    if (gw < T) LN_LOAD(gw);
    for (int row = gw; row < T; row += NGW) {
        const int b = row >> 14;
        f32x4 v[8]; float s = 0.f;
#pragma unroll
        for (int j = 0; j < 8; ++j) v[j] = vn[j];
        if (row + NGW < T) LN_LOAD(row + NGW);
#pragma unroll
        for (int j = 0; j < 8; ++j) s += (v[j][0] + v[j][1]) + (v[j][2] + v[j][3]);
        float mean = wave_sum(s) * (1.f / DM); float s2 = 0.f;
#pragma unroll
        for (int j = 0; j < 8; ++j) { v[j] = v[j] - mean; s2 += (v[j][0] * v[j][0] + v[j][1] * v[j][1]) + (v[j][2] * v[j][2] + v[j][3] * v[j][3]); }
        float rstd = 1.0f / sqrtf(wave_sum(s2) * (1.f / DM) + LN_EPS);
        if (MODE != 0) {
            f32x4* xo = (f32x4*)(xout + (size_t)row * DM) + lane; s = 0.f;
            if (MODE == 1 && lane == 0) { stats_out[2 * row] = mean; stats_out[2 * row + 1] = rstd; }
#pragma unroll
            for (int j = 0; j < 8; ++j) { v[j] = v[j] * rstd * gv[j] + bv[j]; if (MODE == 2) xo[64 * j] = v[j]; s += (v[j][0] + v[j][1]) + (v[j][2] + v[j][3]); }
            if (MODE == 1) {
                mean = wave_sum(s) * (1.f / DM); s2 = 0.f;
#pragma unroll
                for (int j = 0; j < 8; ++j) { v[j] = v[j] - mean; s2 += (v[j][0] * v[j][0] + v[j][1] * v[j][1]) + (v[j][2] * v[j][2] + v[j][3] * v[j][3]); }
                rstd = 1.0f / sqrtf(wave_sum(s2) * (1.f / DM) + LN_EPS);
            }
        }
        if (MODE != 2) {
            const float* sh = ada_shift + (size_t)b * NADA; const float* sc = ada_scale + (size_t)b * NADA;
            u32x2* ao = (u32x2*)(aout + (size_t)row * DM) + lane;
#pragma unroll
            for (int j = 0; j < 8; ++j) { const f32x4 shv = *(const f32x4*)(sh + 256 * j + 4 * lane), scv = *(const f32x4*)(sc + 256 * j + 4 * lane);
                const f32x4 y = v[j] * rstd * (scv + 1.0f) + shv; u32x2 w; w.x = pk2(y[0], y[1]); w.y = pk2(y[2], y[3]); ao[64 * j] = w; }
        }
    }
#undef LN_LOAD
}
__device__ __forceinline__ void p6_scalars_conv(const Params& p, LAS unsigned char* lds) {
    int tid_l = threadIdx.x; asm volatile("" : "+v"(tid_l)); const int tid = tid_l, lane = tid & 63, wave = tid >> 6;
    unsigned char* ws = p.ws;
    const float* gates = (const float*)(ws + WS_GATES);
    float* Fs = (float*)(ws + WS_FS); float* bcs = (float*)(ws + WS_BCS); float* scal = (float*)(ws + WS_SCAL);
    for (int task = blockIdx.x; task < 24; task += gridDim.x) {
        if (task < 16) {
            const int b = task >> 3, h = task & 7; LAS float* wt = (LAS float*)lds;
            const float* gp = gates + ((size_t)b * SEQ + (size_t)tid * 32) * 16 + h;
            float v[32]; float run = 0.f;
#pragma unroll
            for (int i = 0; i < 32; ++i) { run += gp[i * 16]; v[i] = run; }
            float inc = run;
#pragma unroll
            for (int o = 1; o < 64; o <<= 1) { const float t = __shfl_up(inc, o); if (lane >= o) inc += t; }
            if (lane == 63) wt[wave] = inc;
            __syncthreads();
            float off = inc - run;
            for (int w = 0; w < wave; ++w) off += wt[w];
            float* fo = Fs + (size_t)task * SEQ + tid * 32;
#pragma unroll
            for (int i = 0; i < 32; ++i) fo[i] = (v[i] + off) * SQRT_DH;
            __syncthreads();
        } else {
            const int bh = task - 16, b = bh >> 2, h = bh & 3; LAS float* bLs = (LAS float*)lds; LAS float* mls = bLs + 256;
            if (tid < 256) { const float* gp = gates + ((size_t)b * SEQ + (size_t)tid * 64) * 16; float run = 0.f, mx = -INFINITY;
                float* bo = bcs + (size_t)bh * SEQ + tid * 64;
#pragma unroll
                for (int s0 = 0; s0 < 64; s0 += 32) { float lf[32], gi[32];
#pragma unroll
                    for (int s = 0; s < 32; ++s) { lf[s] = gp[(s0 + s) * 16 + 12 + h]; gi[s] = gp[(s0 + s) * 16 + 8 + h]; }
#pragma unroll
                    for (int s = 0; s < 32; ++s) { run += lf[s]; bo[s0 + s] = run; mx = fmaxf(mx, gi[s] - run); } }
                bLs[tid] = run; mls[tid] = run + mx; }
            __syncthreads();
            if (tid == 0) { float m = 0.f;
                for (int k = 0; k < 256; ++k) { const float bl = bLs[k], mn = fmaxf(bl + m, mls[k]); float* so = scal + (size_t)(bh * 256 + k) * 4;
                    so[0] = m; so[1] = mn; so[2] = __expf(bl + m - mn); so[3] = 0.f; m = mn; } }
            __syncthreads();
        }
    }
    const bool spl = gridDim.x > 48; const int nsb = spl ? (int)gridDim.x - 24 : (int)gridDim.x, vb = spl ? (int)blockIdx.x - 24 : (int)blockIdx.x;
    if (vb < 0) return;
    { unsigned* nmax = (unsigned*)(ws + WS_CTRL) + 16; const bf16_t* Zq = (const bf16_t*)(ws + WS_Z);
      const int gtn = vb * NT + tid, pr = gtn & 127, hq = pr >> 4, rst = (nsb * NT) >> 7;
      for (int bb = 0; bb < 2; ++bb) { float mxq = 0.f, mxk = 0.f, mnd = 3.0e38f;
          for (int r = bb * SEQ + (gtn >> 7); r < (bb + 1) * SEQ; r += 4 * rst) { u32x4 zq[4], zk[4];
#pragma unroll
              for (int i = 0; i < 4; ++i) { const bool ok = r + i * rst < (bb + 1) * SEQ; const bf16_t* rp = Zq + (size_t)(r + i * rst) * ZP + 8 * pr;
                  zq[i] = ok ? *(const u32x4*)rp : (u32x4){0u, 0u, 0u, 0u}; zk[i] = ok ? *(const u32x4*)(rp + 1024) : (u32x4){0u, 0u, 0u, 0u}; }
#pragma unroll
              for (int i = 0; i < 4; ++i) { float sq = 0.f, sk = 0.f, sd = 0.f;
#pragma unroll
                  for (int q = 0; q < 4; ++q) { const float ql = __uint_as_float(zq[i][q] << 16), qh = __uint_as_float(zq[i][q] & 0xffff0000u), kl = __uint_as_float(zk[i][q] << 16), kh = __uint_as_float(zk[i][q] & 0xffff0000u);
                      sq += ql * ql + qh * qh; sk += kl * kl + kh * kh; sd += ql * kl + qh * kh; }
#pragma unroll
                  for (int o = 1; o < 2; ++o) { sq = row16_sum(sq); sk = row16_sum(sk); sd = row16_sum(sd); }
                  mxq = fmaxf(mxq, sq); mxk = fmaxf(mxk, sk); if (r + i * rst < (bb + 1) * SEQ) mnd = fminf(mnd, sd); } }
          if ((pr & 15) == 0) { atomicMax(nmax + bb * 16 + hq, __float_as_uint(mxq)); atomicMax(nmax + bb * 16 + 8 + hq, __float_as_uint(mxk));
              const unsigned db = __float_as_uint(mnd); atomicMin(nmax + 32 + bb * 8 + hq, db ^ ((db >> 31) ? 0xFFFFFFFFu : 0x80000000u)); } } }
    const bf16_t* Z = (const bf16_t*)(ws + WS_Z); bf16_t* QKc = (bf16_t*)(ws + WS_QKC);
    const int gt = vb * NT + tid, cgp = gt & 127, c0 = 8 * cgp;
    float cw[4][8], cb[8];
#pragma unroll
    for (int i = 0; i < 8; ++i) { cb[i] = p.conv_b[c0 + i];
#pragma unroll
        for (int j = 0; j < 4; ++j) cw[j][i] = p.conv_w[j * 1024 + c0 + i]; }
    const float osc = c0 >= 512 ? RSQRT_DK : 1.0f;
    for (int rb = gt >> 7; rb < T / 4; rb += (nsb * NT) >> 7) {
        const int r0 = 4 * rb, t0 = r0 & (SEQ - 1);
        u32x4 z[7];
#pragma unroll
        for (int j = 0; j < 7; ++j) z[j] = (t0 - 3 + j >= 0) ? *(const u32x4*)(Z + (size_t)(r0 - 3 + j) * ZP + 3072 + c0) : (u32x4){0u, 0u, 0u, 0u};
#pragma unroll
        for (int rr = 0; rr < 4; ++rr) {
            float a[8];
#pragma unroll
            for (int i = 0; i < 8; ++i) a[i] = cb[i];
#pragma unroll
            for (int j = 0; j < 4; ++j) {
#pragma unroll
                for (int q = 0; q < 4; ++q) { a[2 * q] += cw[j][2 * q] * __uint_as_float(z[rr + j][q] << 16); a[2 * q + 1] += cw[j][2 * q + 1] * __uint_as_float(z[rr + j][q] & 0xffff0000u); } }
            u32x4 o;
#pragma unroll
            for (int q = 0; q < 4; ++q) o[q] = pk2(pg8::silu_f(a[2 * q]) * osc, pg8::silu_f(a[2 * q + 1]) * osc);
            *(u32x4*)(QKc + (size_t)(r0 + rr) * 1024 + c0) = o;
        }
    }
}

__device__ __forceinline__ void p7_mlstm_local(const Params& p, LAS unsigned char* lds) {
    int tid_l = threadIdx.x; asm volatile("" : "+v"(tid_l)); const int tid = tid_l, lane = tid & 63, wave = __builtin_amdgcn_readfirstlane(tid >> 6), fr = lane & 15, fq = lane >> 4;
    unsigned char* ws = p.ws;
    const float* gates = (const float*)(ws + WS_GATES); const float* bcs = (const float*)(ws + WS_BCS); const float* scal = (const float*)(ws + WS_SCAL);
    const bf16_t* Z = (const bf16_t*)(ws + WS_Z); const bf16_t* QKc = (const bf16_t*)(ws + WS_QKC);
    bf16_t* Cst = (bf16_t*)(ws + WS_CST); float* nst = (float*)(ws + WS_NST);
    { const int gi = blockIdx.x * NT + tid;
      if (gi < 1024) { const int bhq = gi >> 6, qb = gi & 63, bq = bhq >> 3, hq = bhq & 7; const unsigned* nmax = (const unsigned*)(ws + WS_CTRL) + 16;
          const float qn2 = __uint_as_float(nmax[bq * 16 + hq]), kn2 = __uint_as_float(nmax[bq * 16 + 8 + hq]);
          const unsigned dk_ = nmax[32 + bq * 8 + hq]; const float dmin = __uint_as_float(dk_ ^ ((dk_ >> 31) ? 0x80000000u : 0xFFFFFFFFu));
          const float M = (105.0f + (1.01f * sqrtf(qn2 * kn2) - fminf(dmin, 0.f) * 1.01f + fmaxf(dmin, 0.f) * 0.0f) * RSQRT_DK) * SQRT_DH;
          const float* F = (const float*)(ws + WS_FS) + (size_t)bhq * SEQ; const float f0 = F[qb * 256];
          int lo = 0, hi = 4 * qb;
          while (lo < hi) { const int mid = (lo + hi) >> 1; if (f0 - F[64 * mid + 63] < -M) lo = mid + 1; else hi = mid; }
          ((int*)(ws + WS_CTRL + 1024))[gi] = lo; } }
    LAS bf16_t* wKt = (LAS bf16_t*)lds;
    LAS bf16_t* Vt = (LAS bf16_t*)(lds + 18432);
    LAS float* wts = (LAS float*)(lds + 55296);
    LAS float* nred = (LAS float*)(lds + 55808);
    u32x4 kreg[2], vreg[4]; float sreg[4] = {0.f, 0.f, 0.f, 0.f};
#define P7_LOAD(u_) do { const int bh_ = (u_) >> 8, k_ = (u_) & 255, b_ = bh_ >> 2, h_ = bh_ & 3; const size_t r0_ = (size_t)b_ * SEQ + 64 * k_; \
        if (tid < 64) { const float* bp_ = bcs + (size_t)bh_ * SEQ + 64 * k_; sreg[0] = bp_[63]; sreg[1] = bp_[tid]; sreg[2] = gates[(r0_ + tid) * 16 + 8 + h_]; sreg[3] = scal[(size_t)(u_) * 4 + 1]; } \
        _Pragma("unroll") for (int i = 0; i < 2; ++i) { const int pc = tid + NT * i, s = pc >> 4, d0 = (pc & 15) * 8; kreg[i] = *(const u32x4*)(QKc + (r0_ + s) * 1024 + 512 + 128 * h_ + d0); } \
        _Pragma("unroll") for (int i = 0; i < 4; ++i) { const int pc = tid + NT * i, s = pc >> 5, v0 = (pc & 31) * 8; vreg[i] = *(const u32x4*)(Z + (r0_ + s) * ZP + 4096 + 256 * h_ + v0); } } while (0)
    if ((int)blockIdx.x < 2048) P7_LOAD((int)blockIdx.x);
    for (int u = blockIdx.x; u < 2048; u += gridDim.x) {
        if (tid < 64) wts[tid] = __expf(sreg[0] - sreg[1] + sreg[2] - sreg[3]);
        LDS_BARRIER();
#pragma unroll
        for (int i = 0; i < 2; ++i) { const int pc = tid + NT * i, s = pc >> 4, d0 = (pc & 15) * 8; const float w = wts[s];
            const u32x4 kv = kreg[i];
#pragma unroll
            for (int q = 0; q < 4; ++q) { const unsigned pr = pk2(__uint_as_float(kv[q] << 16) * w, __uint_as_float(kv[q] & 0xffff0000u) * w);
                wKt[tsw(d0 + 2 * q, s)] = (bf16_t)(pr & 0xffffu); wKt[tsw(d0 + 2 * q + 1, s)] = (bf16_t)(pr >> 16); } }
#pragma unroll
        for (int i = 0; i < 4; ++i) { const int pc = tid + NT * i, s = pc >> 5, v0 = (pc & 31) * 8;
            const u32x4 vv = vreg[i];
#pragma unroll
            for (int q = 0; q < 4; ++q) { Vt[tsw(v0 + 2 * q, s)] = (bf16_t)(vv[q] & 0xffffu); Vt[tsw(v0 + 2 * q + 1, s)] = (bf16_t)(vv[q] >> 16); } }
        if (u + (int)gridDim.x < 2048) P7_LOAD(u + (int)gridDim.x);
        LDS_BARRIER();
        f32x4 acc[8][2];
#pragma unroll
        for (int dt = 0; dt < 8; ++dt) { acc[dt][0] = (f32x4){0.f, 0.f, 0.f, 0.f}; acc[dt][1] = (f32x4){0.f, 0.f, 0.f, 0.f}; }
#pragma unroll
        for (int ks = 0; ks < 2; ++ks) {
            bf16x8 bfr[2];
#pragma unroll
            for (int vt = 0; vt < 2; ++vt) bfr[vt] = *(const LAS bf16x8*)(Vt + tsw(32 * wave + 16 * vt + fr, 32 * ks + 8 * fq));
#pragma unroll
            for (int dt = 0; dt < 8; ++dt) { const bf16x8 a = *(const LAS bf16x8*)(wKt + tsw(16 * dt + fr, 32 * ks + 8 * fq));
                acc[dt][0] = __builtin_amdgcn_mfma_f32_16x16x32_bf16(a, bfr[0], acc[dt][0], 0, 0, 0);
                acc[dt][1] = __builtin_amdgcn_mfma_f32_16x16x32_bf16(a, bfr[1], acc[dt][1], 0, 0, 0); }
        }
        bf16_t* co = Cst + (size_t)u * 32768;
#pragma unroll
        for (int dt = 0; dt < 8; ++dt)
#pragma unroll
            for (int vt = 0; vt < 2; ++vt) { u32x2 w; w.x = pk2(acc[dt][vt][0], acc[dt][vt][1]); w.y = pk2(acc[dt][vt][2], acc[dt][vt][3]);
                *(u32x2*)(co + (size_t)(32 * wave + 16 * vt + fr) * 128 + 16 * dt + 4 * fq) = w; }
        { const int d = tid & 127, part = tid >> 7; float s = 0.f;
#pragma unroll
            for (int i = 0; i < 16; ++i) s += bf2f(wKt[tsw(d, 16 * part + i)]);
            nred[part * 128 + d] = s; }
        LDS_BARRIER();
        if (tid < 128) nst[(size_t)u * 128 + tid] = (nred[tid] + nred[128 + tid]) + (nred[256 + tid] + nred[384 + tid]);
        LDS_BARRIER();
    }
#undef P7_LOAD
}

constexpr int SCAN_CHUNKS = 258;
__device__ __forceinline__ void p8_scan_chunk(const Params& p, int chunk) {
    unsigned char* ws = p.ws; const float* scal = (const float*)(ws + WS_SCAL);
    unsigned* Cst = (unsigned*)(ws + WS_CST); float* nst = (float*)(ws + WS_NST);
    if (chunk < 256) { const int it = chunk * NT + (int)threadIdx.x;
        const int bh = it >> 14, e = it & 16383; unsigned* cp = Cst + (size_t)bh * 256 * 16384 + e; const float* sp = scal + (size_t)bh * 256 * 4 + 2;
        float s0 = 0.f, s1 = 0.f;
        for (int k0 = 0; k0 < 256; k0 += 8) { unsigned loc[8]; float dk[8];
#pragma unroll
            for (int j = 0; j < 8; ++j) { loc[j] = cp[(size_t)(k0 + j) * 16384]; dk[j] = sp[(k0 + j) * 4]; }
#pragma unroll
            for (int j = 0; j < 8; ++j) { cp[(size_t)(k0 + j) * 16384] = pk2(s0, s1);
                s0 = dk[j] * s0 + __uint_as_float(loc[j] << 16); s1 = dk[j] * s1 + __uint_as_float(loc[j] & 0xffff0000u); } }
    } else { const int it = (chunk - 256) * NT + (int)threadIdx.x; const int bh = it >> 7, d = it & 127; float* np = nst + (size_t)bh * 256 * 128 + d; const float* sp = scal + (size_t)bh * 256 * 4 + 2;
        float s = 0.f;
        for (int k0 = 0; k0 < 256; k0 += 16) { float loc[16], dk[16];
#pragma unroll
            for (int j = 0; j < 16; ++j) { loc[j] = np[(k0 + j) * 128]; dk[j] = sp[(k0 + j) * 4]; }
#pragma unroll
            for (int j = 0; j < 16; ++j) { np[(k0 + j) * 128] = s; s = dk[j] * s + loc[j]; } } }
}
__device__ __forceinline__ void p9_mlstm_out(const Params& p, LAS unsigned char* lds) {
    int tid_l = threadIdx.x; asm volatile("" : "+v"(tid_l)); const int tid = tid_l, lane = tid & 63, wave = __builtin_amdgcn_readfirstlane(tid >> 6), fr = lane & 15, fq = lane >> 4;
    unsigned char* ws = p.ws;
    const float* gates = (const float*)(ws + WS_GATES); const float* bcs = (const float*)(ws + WS_BCS); const float* scal = (const float*)(ws + WS_SCAL);
    const bf16_t* Z = (const bf16_t*)(ws + WS_Z); const bf16_t* QKc = (const bf16_t*)(ws + WS_QKC);
    const bf16_t* Cst = (const bf16_t*)(ws + WS_CST); const float* nst = (const float*)(ws + WS_NST); bf16_t* Y = (bf16_t*)(ws + WS_A);
    LAS bf16_t* Qs = (LAS bf16_t*)lds;
    LAS bf16_t* Ks = (LAS bf16_t*)(lds + 17408);
    LAS bf16_t* Vt = (LAS bf16_t*)(lds + 34816);
    LAS bf16_t* St = (LAS bf16_t*)(lds + 71680);
    LAS float* fb = (LAS float*)(lds + 80896);
    LAS float* bt = fb; LAS float* ig = fb + 64; LAS float* mt = fb + 128; LAS float* inter = fb + 192; LAS float* scl = fb + 256; LAS float* ssq = fb + 320; LAS float* nprev = fb + 384; LAS float* ssqw = fb + 512;
    u32x4 qreg[2], kreg[2], vreg[4]; float sreg[2] = {0.f, 0.f}; float mpn = 0.f;
#define P9_LOAD(u_) do { const int bh_ = (u_) >> 8, k_ = (u_) & 255, b_ = bh_ >> 2, h_ = bh_ & 3; const size_t r0_ = (size_t)b_ * SEQ + 64 * k_; \
        _Pragma("unroll") for (int i = 0; i < 2; ++i) { const int pc = tid + NT * i, s = pc >> 4, d0 = (pc & 15) * 8; \
            qreg[i] = *(const u32x4*)(QKc + (r0_ + s) * 1024 + 128 * h_ + d0); kreg[i] = *(const u32x4*)(QKc + (r0_ + s) * 1024 + 512 + 128 * h_ + d0); } \
        _Pragma("unroll") for (int i = 0; i < 4; ++i) { const int pc = tid + NT * i, s = pc >> 5, v0 = (pc & 31) * 8; vreg[i] = *(const u32x4*)(Z + (r0_ + s) * ZP + 4096 + 256 * h_ + v0); } \
        mpn = scal[(size_t)(u_) * 4 + 0]; \
        if (tid < 64) { sreg[0] = bcs[(size_t)bh_ * SEQ + 64 * k_ + tid]; sreg[1] = gates[(r0_ + tid) * 16 + 8 + h_]; } \
        else if (tid < 192) sreg[0] = nst[(size_t)(u_) * 128 + (tid - 64)]; } while (0)
    if ((int)blockIdx.x < 2048) P9_LOAD((int)blockIdx.x);
    for (int u = blockIdx.x; u < 2048; u += gridDim.x) {
        const int bh = u >> 8, k = u & 255, b = bh >> 2, h = bh & 3; const size_t row0 = (size_t)b * SEQ + 64 * k;
        const float mprev = mpn;
        bf16x8 cfr[2][4];
#pragma unroll
        for (int vt = 0; vt < 2; ++vt)
#pragma unroll
            for (int ks = 0; ks < 4; ++ks) cfr[vt][ks] = *(const bf16x8*)(Cst + (size_t)u * 32768 + (size_t)(32 * wave + 16 * vt + fr) * 128 + 32 * ks + 8 * fq);
#pragma unroll
        for (int i = 0; i < 2; ++i) { const int pc = tid + NT * i, s = pc >> 4, d0 = (pc & 15) * 8;
            *(LAS u32x4*)(Qs + s * 136 + d0) = qreg[i]; *(LAS u32x4*)(Ks + s * 136 + d0) = kreg[i]; }
#pragma unroll
        for (int i = 0; i < 4; ++i) { const int pc = tid + NT * i, s = pc >> 5, v0 = (pc & 31) * 8;
            const u32x4 vv = vreg[i];
#pragma unroll
            for (int q = 0; q < 4; ++q) { Vt[tsw(v0 + 2 * q, s)] = (bf16_t)(vv[q] & 0xffffu); Vt[tsw(v0 + 2 * q + 1, s)] = (bf16_t)(vv[q] >> 16); } }
        if (tid < 64) { bt[tid] = sreg[0]; ig[tid] = sreg[1];
            float pm = sreg[1] - sreg[0];
#pragma unroll
            for (int o = 1; o < 64; o <<= 1) { const float v = __shfl_up(pm, o); if (lane >= o) pm = fmaxf(pm, v); }
            const float mx = sreg[0] + fmaxf(mprev, pm); mt[tid] = mx; inter[tid] = __expf(sreg[0] + mprev - mx); }
        else if (tid < 192) nprev[tid - 64] = sreg[0];
        if (u + (int)gridDim.x < 2048) P9_LOAD(u + (int)gridDim.x);
        LDS_BARRIER();
        const int st = wave >> 1, tt0 = 2 * (wave & 1);
        f32x4 sacc[2] = {{0.f, 0.f, 0.f, 0.f}, {0.f, 0.f, 0.f, 0.f}};
#pragma unroll
        for (int ks = 0; ks < 4; ++ks) { const bf16x8 a = *(const LAS bf16x8*)(Ks + (16 * st + fr) * 136 + 32 * ks + 8 * fq);
#pragma unroll
            for (int j = 0; j < 2; ++j) { const bf16x8 bq = *(const LAS bf16x8*)(Qs + (16 * (tt0 + j) + fr) * 136 + 32 * ks + 8 * fq);
                sacc[j] = __builtin_amdgcn_mfma_f32_16x16x32_bf16(a, bq, sacc[j], 0, 0, 0); } }
        LDS_BARRIER();
#pragma unroll
        for (int j = 0; j < 2; ++j) { const int t = 16 * (tt0 + j) + fr; const float base = bt[t] - mt[t]; float o[4];
#pragma unroll
            for (int i = 0; i < 4; ++i) { const int s = 16 * st + 4 * fq + i; o[i] = (s <= t) ? sacc[j][i] * __expf(base - bt[s] + ig[s]) : 0.f; }
            u32x2 w; w.x = pk2(o[0], o[1]); w.y = pk2(o[2], o[3]); *(LAS u32x2*)(St + t * 72 + 16 * st + 4 * fq) = w; }
        LDS_BARRIER();
        u32x2 obr[4][2]; f32x4 gr[2];
#pragma unroll
        for (int vt = 0; vt < 2; ++vt) { const int v = 32 * wave + 16 * vt + 4 * fq; gr[vt] = *(const f32x4*)(p.ml_ng + 256 * h + v);
#pragma unroll
            for (int tt = 0; tt < 4; ++tt) obr[tt][vt] = *(const u32x2*)(Z + (row0 + 16 * tt + fr) * ZP + 5120 + 256 * h + v); }
        { const int t = tid >> 3, part = tid & 7; float rs = 0.f, qn = 0.f;
            { const u32x4 sv = *(const LAS u32x4*)(St + t * 72 + 8 * part);
#pragma unroll
              for (int i = 0; i < 4; ++i) rs += __uint_as_float(sv[i] << 16) + __uint_as_float(sv[i] & 0xffff0000u); }
#pragma unroll
            for (int hq = 0; hq < 2; ++hq) { const u32x4 qv = *(const LAS u32x4*)(Qs + t * 136 + 16 * part + 8 * hq);
#pragma unroll
              for (int i = 0; i < 4; ++i) { const f32x4 nv = *(const LAS f32x4*)(nprev + 16 * part + 8 * hq + 4 * (i >> 1));
                  qn += __uint_as_float(qv[i] << 16) * nv[2 * (i & 1)] + __uint_as_float(qv[i] & 0xffff0000u) * nv[2 * (i & 1) + 1]; } }
            rs = oct_sum(rs); qn = oct_sum(qn);
            if (part == 0) { const float den = inter[t] * qn + rs; scl[t] = 1.0f / fmaxf(fabsf(den), __expf(-mt[t])); ssq[t] = 0.f; } }
        f32x4 acc[2][4];
#pragma unroll
        for (int vt = 0; vt < 2; ++vt)
#pragma unroll
            for (int tt = 0; tt < 4; ++tt) acc[vt][tt] = (f32x4){0.f, 0.f, 0.f, 0.f};
#pragma unroll
        for (int ks = 0; ks < 4; ++ks)
#pragma unroll
            for (int tt = 0; tt < 4; ++tt) { const bf16x8 bq = *(const LAS bf16x8*)(Qs + (16 * tt + fr) * 136 + 32 * ks + 8 * fq);
                acc[0][tt] = __builtin_amdgcn_mfma_f32_16x16x32_bf16(cfr[0][ks], bq, acc[0][tt], 0, 0, 0);
                acc[1][tt] = __builtin_amdgcn_mfma_f32_16x16x32_bf16(cfr[1][ks], bq, acc[1][tt], 0, 0, 0); }
#pragma unroll
        for (int tt = 0; tt < 4; ++tt) { const float it = inter[16 * tt + fr]; acc[0][tt] = acc[0][tt] * it; acc[1][tt] = acc[1][tt] * it; }
#pragma unroll
        for (int ks = 0; ks < 2; ++ks) { bf16x8 av[2];
#pragma unroll
            for (int vt = 0; vt < 2; ++vt) av[vt] = *(const LAS bf16x8*)(Vt + tsw(32 * wave + 16 * vt + fr, 32 * ks + 8 * fq));
#pragma unroll
            for (int tt = 0; tt < 4; ++tt) { const bf16x8 bs = *(const LAS bf16x8*)(St + (16 * tt + fr) * 72 + 32 * ks + 8 * fq);
                acc[0][tt] = __builtin_amdgcn_mfma_f32_16x16x32_bf16(av[0], bs, acc[0][tt], 0, 0, 0);
                acc[1][tt] = __builtin_amdgcn_mfma_f32_16x16x32_bf16(av[1], bs, acc[1][tt], 0, 0, 0); } }
        LDS_BARRIER();
#pragma unroll
        for (int tt = 0; tt < 4; ++tt) { const float sc = scl[16 * tt + fr]; float q = 0.f;
#pragma unroll
            for (int vt = 0; vt < 2; ++vt) { acc[vt][tt] = acc[vt][tt] * sc; q += (acc[vt][tt][0] * acc[vt][tt][0] + acc[vt][tt][1] * acc[vt][tt][1]) + (acc[vt][tt][2] * acc[vt][tt][2] + acc[vt][tt][3] * acc[vt][tt][3]); }
            q = swap32_sum(swap16_sum(q));
            if (fq == 0) ssqw[wave * 64 + 16 * tt + fr] = q; }
        LDS_BARRIER();
        if (tid < 64) { float s = 0.f;
#pragma unroll
            for (int w = 0; w < 8; ++w) s += ssqw[w * 64 + tid];
            ssq[tid] = s; }
        LDS_BARRIER();
#pragma unroll
        for (int tt = 0; tt < 4; ++tt) { const int t = 16 * tt + fr; const float rn = 1.0f / sqrtf(ssq[t] * (1.f / 256.f) + LN_EPS);
#pragma unroll
            for (int vt = 0; vt < 2; ++vt) { const int v = 32 * wave + 16 * vt + 4 * fq;
                const f32x4 g = gr[vt]; const u32x2 ob = obr[tt][vt];
                const f32x4 y = acc[vt][tt] * rn * g;
                u32x2 w; w.x = pk2(y[0] * __uint_as_float(ob.x << 16), y[1] * __uint_as_float(ob.x & 0xffff0000u)); w.y = pk2(y[2] * __uint_as_float(ob.y << 16), y[3] * __uint_as_float(ob.y & 0xffff0000u));
                *(u32x2*)(Y + (row0 + t) * DM + 1024 + 256 * h + v) = w; } }
        LDS_BARRIER();
    }
#undef P9_LOAD
}
}
namespace fa {
constexpr int D = 128, KVP = 6144, OP = 2048;
constexpr float THR = 8.f;
constexpr bool WSKIP = false;
constexpr float SCALE = 0.08838834764831845f;
constexpr int NW = 8, QBLK = 32, KVBLK = 64, QB = NW * QBLK;
constexpr int SHM_V = KVBLK * D * 2, SHM_K = KVBLK * D * 2;
constexpr int LDS_BYTES = 2 * SHM_V + 2 * SHM_K + NW * 64 * 4;
constexpr int FL_OFF = 69632;
using bf16 = __hip_bfloat16;
typedef short bf16x8 __attribute__((ext_vector_type(8)));
typedef short s16x4 __attribute__((ext_vector_type(4)));
typedef float f32x16 __attribute__((ext_vector_type(16)));
typedef float f32x4 __attribute__((ext_vector_type(4)));
typedef unsigned u32x4 __attribute__((ext_vector_type(4)));
template <class A, class Bt> struct same_t { static constexpr bool v = false; };
template <class A> struct same_t<A, A> { static constexpr bool v = true; };

#define KSWZ(row, colB) ((row) * 256 + ((colB) ^ (((row) & 7) << 4)))
#define SBAR() __builtin_amdgcn_sched_barrier(0)
__device__ __forceinline__ int v_st(int k, int c) { const int kk = (k & ~0xC) | ((k & 4) << 1) | ((k & 8) >> 1); return ((kk >> 3) * 4 + (c >> 5)) * 512 + ((kk & 7) * 32 + (c & 31)) * 2; }
__device__ __forceinline__ int v_rd_base(int lane) { return ((lane & 3) << 3) | (((lane >> 2) & 3) << 6) | (((lane >> 4) & 1) << 5) | (((lane >> 5) & 1) << 8); }
constexpr int v_rd_off(int d0, int ks, int half) { return d0 * 512 + ks * 4096 + half * 2048; }
__device__ __forceinline__ int crow(int r, int hi) { return (r & 3) + 8 * (r >> 2) + 4 * hi; }
__device__ __forceinline__ unsigned cvtpk(float lo, float hi) { return pg8::cvt_pk_bf16(lo, hi); }
__device__ __forceinline__ bf16x8 pack8(f32x4 a, f32x4 b) {
    u32x4 w = {cvtpk(a[0], a[1]), cvtpk(a[2], a[3]), cvtpk(b[0], b[1]), cvtpk(b[2], b[3])};
    return *reinterpret_cast<bf16x8*>(&w);
}
template <class T> __device__ __forceinline__ bf16x8 load8(const T* p) {
    if constexpr (same_t<T, float>::v) { return pack8(*(const f32x4*)p, *(const f32x4*)(p + 4)); }
    else { return *reinterpret_cast<const bf16x8*>(p); }
}
__device__ __forceinline__ void split3(float x, unsigned& h, unsigned& m, unsigned& l) {
    const unsigned xb = __float_as_uint(x); h = xb >> 16; const float r = x - __uint_as_float(xb & 0xffff0000u);
    const unsigned rb = __float_as_uint(r); m = rb >> 16; const float r2 = r - __uint_as_float(rb & 0xffff0000u);
    l = __float_as_uint(r2) >> 16;
}
__device__ __forceinline__ bf16x8 aug_q(float x, int hi) { unsigned h, m, l; split3(x, h, m, l);
    u32x4 w = {h | (m << 16), l | 0x3F800000u, 0x3F803F80u, 0u}; if (hi) w = u32x4{0u, 0u, 0u, 0u}; return *reinterpret_cast<bf16x8*>(&w); }
__device__ __forceinline__ bf16x8 aug_k(float x, int hi) { unsigned h, m, l; split3(x, h, m, l);
    u32x4 w = {0x3F803F80u, 0x3F80u | (h << 16), m | (l << 16), 0u}; if (hi) w = u32x4{0u, 0u, 0u, 0u}; return *reinterpret_cast<bf16x8*>(&w); }
__device__ __forceinline__ void mask_tile(f32x16& p0, f32x16& p1, int dq, unsigned W) {
    const float NEG = -__builtin_inff();
#pragma unroll
    for (int r = 0; r < 16; ++r) {
        const int c = (r & 3) + 8 * (r >> 2);
        if ((unsigned)(dq - c) >= W) p0[r] = NEG;
        if ((unsigned)(dq - c - 32) >= W) p1[r] = NEG;
    }
}
__device__ __forceinline__ void partialSM(f32x16& p0, f32x16& p1, float& m_reg, float& mn, float& alpha) {
    float pmax = p0[0]; for (int r = 1; r < 16; ++r) pmax = fmaxf(pmax, p0[r]); for (int r = 0; r < 16; ++r) pmax = fmaxf(pmax, p1[r]);
    { auto rr = __builtin_amdgcn_permlane32_swap(__float_as_uint(pmax), __float_as_uint(pmax), false, false);
      pmax = fmaxf(__uint_as_float(rr[0]), __uint_as_float(rr[1])); }
    constexpr float C2 = 1.4426950408889634f * SCALE;
    if (__builtin_expect(__all((pmax - m_reg) * SCALE <= THR), 1)) { mn = m_reg; alpha = 1.f; }
    else { mn = fmaxf(m_reg, pmax); alpha = __builtin_amdgcn_exp2f((m_reg - mn) * C2); m_reg = mn; }
    const float mnL = -mn * C2;
    for (int r = 0; r < 16; ++r) p0[r] = fmaf(p0[r], C2, mnL); for (int r = 0; r < 16; ++r) p1[r] = fmaf(p1[r], C2, mnL);
    for (int r = 0; r < 16; ++r) p0[r] = __builtin_amdgcn_exp2f(p0[r]);
}
__device__ __forceinline__ void finishSM(f32x16& p0, f32x16& p1, float alpha, float& l_reg, bf16x8& pa0, bf16x8& pa1, bf16x8& pa2, bf16x8& pa3) {
    for (int r = 0; r < 16; ++r) p1[r] = __builtin_amdgcn_exp2f(p1[r]);
    float ps = 0; for (int r = 0; r < 16; ++r) ps += p0[r]; for (int r = 0; r < 16; ++r) ps += p1[r];
    { auto rr = __builtin_amdgcn_permlane32_swap(__float_as_uint(ps), __float_as_uint(ps), false, false);
      ps = __uint_as_float(rr[0]) + __uint_as_float(rr[1]); }
    l_reg = l_reg * alpha + ps;
#define PK4(P, B_, OUT) do { unsigned a0 = cvtpk(P[B_+0], P[B_+1]), a1 = cvtpk(P[B_+2], P[B_+3]);                          \
        unsigned b0 = cvtpk(P[B_+4], P[B_+5]), b1 = cvtpk(P[B_+6], P[B_+7]);                                             \
        auto r0 = __builtin_amdgcn_permlane32_swap(a0, b0, false, false); auto r1 = __builtin_amdgcn_permlane32_swap(a1, b1, false, false); \
        u32x4 w = {r0[0], r1[0], r0[1], r1[1]}; OUT = *reinterpret_cast<bf16x8*>(&w); } while (0)
    PK4(p0, 0, pa0); PK4(p0, 8, pa1); PK4(p1, 0, pa2); PK4(p1, 8, pa3);
#undef PK4
}
template <int KB, bool SK>
__device__ __forceinline__ void qkt(f32x16& p0, f32x16& p1, const char* K_lds, int r32, int hi, const bf16x8* qr, bool act, bf16x8 qaug, bf16x8 ka0, bf16x8 ka1) {
    if (SK && !act) { const float NEG = -__builtin_inff();
#pragma unroll
        for (int r = 0; r < 16; ++r) { p0[r] = NEG; p1[r] = NEG; } return; }
    p0 = f32x16{}; p1 = f32x16{};
    p0 = __builtin_amdgcn_mfma_f32_32x32x16_bf16(ka0, qaug, p0, 0, 0, 0); p1 = __builtin_amdgcn_mfma_f32_32x32x16_bf16(ka1, qaug, p1, 0, 0, 0);
    const char* kb[4];
#pragma unroll
    for (int dd = 0; dd < 4; ++dd) kb[dd] = K_lds + KB * SHM_K + KSWZ(r32, (dd * 16 + hi * 8) * 2);
#pragma unroll
    for (int d0 = 0; d0 < 8; ++d0) { const char* a = kb[d0 & 3] + (d0 >> 2) * 128;
        bf16x8 b0 = *reinterpret_cast<const bf16x8*>(a);
        bf16x8 b1 = *reinterpret_cast<const bf16x8*>(a + 32 * 256);
        p0 = __builtin_amdgcn_mfma_f32_32x32x16_bf16(b0, qr[d0], p0, 0, 0, 0);
        p1 = __builtin_amdgcn_mfma_f32_32x32x16_bf16(b1, qr[d0], p1, 0, 0, 0); }
}
template <int VB, bool SK>
__device__ __forceinline__ void pv_tile(f32x16* o, int vb0, bf16x8 pa0, bf16x8 pa1, bf16x8 pa2, bf16x8 pa3, bool act) {
    if (SK && !act) return;
#define TRRD(dst, off) asm volatile("ds_read_b64_tr_b16 %0, %1 offset:%2" : "=&v"(dst) : "v"(vb0), "i"(off) : "memory")
#define PV_D0(d0) do { s16x4 l0, l1, l2, l3, h0, h1, h2, h3; constexpr int b_ = VB * SHM_V + v_rd_off(d0, 0, 0);     \
        TRRD(l0, b_); TRRD(h0, b_ + 2048); TRRD(l1, b_ + 4096); TRRD(h1, b_ + 6144); TRRD(l2, b_ + 8192); TRRD(h2, b_ + 10240); TRRD(l3, b_ + 12288); TRRD(h3, b_ + 14336); \
        asm volatile("s_waitcnt lgkmcnt(0)" ::: "memory"); SBAR();                 \
        o[d0] = __builtin_amdgcn_mfma_f32_32x32x16_bf16(pa0, (bf16x8){l0[0], l0[1], l0[2], l0[3], h0[0], h0[1], h0[2], h0[3]}, o[d0], 0, 0, 0);   \
        o[d0] = __builtin_amdgcn_mfma_f32_32x32x16_bf16(pa1, (bf16x8){l1[0], l1[1], l1[2], l1[3], h1[0], h1[1], h1[2], h1[3]}, o[d0], 0, 0, 0);   \
        o[d0] = __builtin_amdgcn_mfma_f32_32x32x16_bf16(pa2, (bf16x8){l2[0], l2[1], l2[2], l2[3], h2[0], h2[1], h2[2], h2[3]}, o[d0], 0, 0, 0);   \
        o[d0] = __builtin_amdgcn_mfma_f32_32x32x16_bf16(pa3, (bf16x8){l3[0], l3[1], l3[2], l3[3], h3[0], h3[1], h3[2], h3[3]}, o[d0], 0, 0, 0); } while (0)
    PV_D0(0); PV_D0(1); PV_D0(2); PV_D0(3);
#undef PV_D0
#undef TRRD
}

template <class TIn, class TOut> struct BlockRef { const TIn* Q; const TIn* K; const TIn* V; TOut* O; const float* F; int P0; int jlo; };
template <class TIn> struct Seam {
    bf16x8 qr[8];
    bf16x8 st_v0, st_v1, st_k0, st_k1; f32x4 sf0, sf1, sf2, sf3;
    f32x4 tq[16];
};
__device__ __forceinline__ int swa_jlo(int P0, int W) { const int lowk = P0 - W + 1; return lowk > 0 ? lowk / KVBLK : 0; }
#define ROW(p, k0, rr) ((p) + (size_t)((k0) + (rr)) * KVP + sc)
#define VMW() asm volatile("s_waitcnt vmcnt(0)" ::: "memory")
#define VMWN(n) asm volatile("s_waitcnt vmcnt(%0)" :: "i"(n) : "memory")
#define SLOAD_H(Kp, Vp, k0) do { S.st_v0 = load8<TIn>(ROW(Vp, k0, sr)); S.st_v1 = load8<TIn>(ROW(Vp, k0, 32 + sr));              \
                         S.st_k0 = load8<TIn>(ROW(Kp, k0, sr)); S.st_k1 = load8<TIn>(ROW(Kp, k0, 32 + sr)); } while (0)
#define SWRITE_HK(bf) do { *(bf16x8*)(K_lds + (bf) * SHM_K + kws) = S.st_k0; *(bf16x8*)(K_lds + (bf) * SHM_K + kws + 32 * 256) = S.st_k1; } while (0)
#define SWRITE_HV(bf) do { *(bf16x8*)(V_lds + (bf) * SHM_V + vst0) = S.st_v0; *(bf16x8*)(V_lds + (bf) * SHM_V + vst1) = S.st_v1; } while (0)
#define SWRITE_H(bf) do { SWRITE_HV(bf); SWRITE_HK(bf); } while (0)
#define SLOAD_F(p, k0) do { S.sf0 = *(const f32x4*)ROW(p, k0, sr); S.sf1 = *(const f32x4*)(ROW(p, k0, sr) + 4);                \
                            S.sf2 = *(const f32x4*)ROW(p, k0, 32 + sr); S.sf3 = *(const f32x4*)(ROW(p, k0, 32 + sr) + 4); } while (0)
#define SWRITE_KF(bf) do { *(bf16x8*)(K_lds + (bf) * SHM_K + kws) = pack8(S.sf0, S.sf1); *(bf16x8*)(K_lds + (bf) * SHM_K + kws + 32 * 256) = pack8(S.sf2, S.sf3); } while (0)
#define SWRITE_VF(bf) do { *(bf16x8*)(V_lds + (bf) * SHM_V + vst0) = pack8(S.sf0, S.sf1); *(bf16x8*)(V_lds + (bf) * SHM_V + vst1) = pack8(S.sf2, S.sf3); } while (0)
template <class TIn, class TOut>
__device__ __forceinline__ void causal_swa_prime(const BlockRef<TIn, TOut>& cur, int W, char* lds, Seam<TIn>& S) {
    constexpr bool F32 = same_t<TIn, float>::v;
    int tid_l = threadIdx.x; asm volatile("" : "+v"(tid_l)); const int tid = tid_l, wid = __builtin_amdgcn_readfirstlane(tid >> 6), lane = tid & 63, r32 = lane & 31, hi = lane >> 5;
    const int sr = tid >> 4, sc = (tid & 15) * 8, kws = KSWZ(sr, sc * 2); char* K_lds = lds + 2 * SHM_V;
    const int kb0 = ((cur.P0 + QB - 1) / KVBLK) * KVBLK;
    for (int d0 = 0; d0 < 8; ++d0) S.qr[d0] = load8<TIn>(cur.Q + (size_t)(wid * QBLK + r32) * KVP + d0 * 16 + hi * 8);
    if constexpr (F32) { SLOAD_F((const float*)cur.K, kb0); VMW(); SWRITE_KF(0); SBAR(); SLOAD_F((const float*)cur.V, kb0); }
    else { SLOAD_H(cur.K, cur.V, kb0); VMW(); SWRITE_HK(0); }
    __syncthreads();
}
template <class TIn, class TOut>
__device__ __forceinline__ void causal_swa_block(const BlockRef<TIn, TOut>& cur, const BlockRef<TIn, TOut>& nxt, int skv, int W, char* lds, Seam<TIn>& S) {
    constexpr bool F32 = same_t<TIn, float>::v;
    int tid_l = threadIdx.x; asm volatile("" : "+v"(tid_l)); const int tid = tid_l, wid = __builtin_amdgcn_readfirstlane(tid >> 6), lane = tid & 63, r32 = lane & 31, hi = lane >> 5;
    const int j_lo = cur.jlo;
    int j_hi = (cur.P0 + QB - 1) / KVBLK + 1; if (j_hi > skv / KVBLK) j_hi = skv / KVBLK;
    const int NT = j_hi - j_lo;
    const int kbn = ((nxt.P0 + QB - 1) / KVBLK) * KVBLK;
    const int qlo = cur.P0 + wid * QBLK, qm = qlo + r32 - 4 * hi;
    float* Fl = (float*)(lds + FL_OFF);
    float fqv;
    { const float fbase = __uint_as_float(__builtin_amdgcn_readfirstlane(__float_as_uint(cur.F[cur.P0]))); fqv = cur.F[cur.P0 + wid * QBLK + r32] - fbase;
      for (int i4 = cur.jlo * (KVBLK / 4) + tid; i4 < (cur.P0 + QB) / 4; i4 += 64 * NW) { const f32x4 v = ((const f32x4*)cur.F)[i4]; ((f32x4*)Fl)[i4] = v - fbase; } }
    asm volatile("s_waitcnt lgkmcnt(0)" ::: "memory"); __builtin_amdgcn_s_barrier(); asm volatile("" ::: "memory");
#define KAUG(t_, a_, b_) const bf16x8 qaug = aug_q(fqv, hi), a_ = aug_k(-Fl[KBASE(t_) + r32], hi), b_ = aug_k(-Fl[KBASE(t_) + 32 + r32], hi)
#define FLOADK(t) do { } while (0)
    char* V_lds = lds; char* K_lds = lds + 2 * SHM_V;
    float* ws = (float*)(lds + 2 * SHM_V + 2 * SHM_K) + wid * 64; float* li_l = ws, * al_l = ws + 32;
    float m_reg = -1e30f, l_reg = 0; f32x16 o[4] = {};
    const int sr = tid >> 4, sc = (tid & 15) * 8, vst0 = v_st(sr, sc), vst1 = v_st(32 + sr, sc), kws = KSWZ(sr, sc * 2);
    const int vb0 = (int)(uintptr_t)V_lds + v_rd_base(lane);
    const TIn* Kh = cur.K; const TIn* Vh = cur.V;
#define RESC(a) do { if (__any((a) < 1.f)) { if (hi == 0) al_l[r32] = (a); asm volatile("s_waitcnt lgkmcnt(0)" ::: "memory");              \
                     for (int d_ = 0; d_ < 4; ++d_) for (int r = 0; r < 16; ++r) o[d_][r] *= al_l[crow(r, hi)]; } } while (0)
#define KBASE(t) ((j_hi - 1 - (t)) * KVBLK)
#define ACT(t) (KBASE(t) <= qlo + QBLK - 1 && KBASE(t) + KVBLK - 1 >= qlo - W + 1)
#define MASKT(P0_, P1_, t) do { const int kb_ = KBASE(t); if ((!SK || ACT(t)) && (kb_ + KVBLK - 1 > qlo || kb_ <= qlo + QBLK - 1 - W)) mask_tile(P0_, P1_, qm - kb_, (unsigned)W); } while (0)
    constexpr int NQL = F32 ? 16 : 8;
    constexpr bool SK = WSKIP && !F32;
#define SEAM_K0() do { VMWN(NQL); if constexpr (F32) { SWRITE_KF(0); SBAR(); SLOAD_F((const float*)nxt.V, kbn); } else { SWRITE_HK(0); } SBAR(); } while (0)
    f32x16 pA0, pA1, pB0, pB1; float mnA, mnB, alA, alB; bf16x8 pa0, pa1, pa2, pa3;
    if constexpr (F32) { VMW(); SWRITE_VF(0); SBAR(); } else { SWRITE_HV(0); SBAR(); }
    bf16x8 kh0, kh1, qaug0; { KAUG(0, a_, b_); kh0 = a_; kh1 = b_; qaug0 = qaug; }
    if (NT > 1) { if constexpr (F32) SLOAD_F((const float*)Kh, KBASE(1)); else SLOAD_H(Kh, Vh, KBASE(1)); FLOADK(1); }
    SBAR(); qkt<0, SK>(pA0, pA1, K_lds, r32, hi, S.qr, ACT(0), qaug0, kh0, kh1);
    if constexpr (F32) { if (NT > 1) { VMW(); SWRITE_KF(1); SBAR(); SLOAD_F((const float*)Vh, KBASE(1)); } }
    MASKT(pA0, pA1, 0); partialSM(pA0, pA1, m_reg, mnA, alA);
    if (NT > 1) { VMW(); if constexpr (F32) { SWRITE_VF(1); SBAR(); if (NT > 2) SLOAD_F((const float*)Kh, KBASE(2)); } else SWRITE_H(1); }
    __syncthreads();
#define HALF_STEP(PX0, PX1, mnX, alX, PY0, PY1, alY, t, KB, VB, SB) do {                                                      \
        SBAR(); { KAUG(t, kx0, kx1); qkt<KB, SK>(PX0, PX1, K_lds, r32, hi, S.qr, ACT(t), qaug, kx0, kx1); }                  \
        finishSM(PY0, PY1, alY, l_reg, pa0, pa1, pa2, pa3); SBAR();                                                           \
        if ((t) + 1 < NT) { if constexpr (F32) { VMW(); SWRITE_KF(SB); SBAR(); SLOAD_F((const float*)Vh, KBASE((t) + 1)); }  \
                            else { SLOAD_H(Kh, Vh, KBASE((t) + 1)); } FLOADK((t) + 1); SBAR(); }                                               \
        pv_tile<VB, SK>(o, vb0, pa0, pa1, pa2, pa3, ACT((t) - 1)); MASKT(PX0, PX1, (t)); partialSM(PX0, PX1, m_reg, mnX, alX);                                        \
        __syncthreads();                                                                                                      \
        if ((t) + 1 < NT) { VMW(); if constexpr (F32) { SWRITE_VF(SB); SBAR(); if ((t) + 2 < NT) SLOAD_F((const float*)Kh, KBASE((t) + 2)); } \
                            else { SWRITE_H(SB); } }                                                                          \
        RESC(alX); __syncthreads(); } while (0)
    for (int t = 1; t + 1 < NT; t += 2) {
        HALF_STEP(pB0, pB1, mnB, alB, pA0, pA1, alA, t, 1, 0, 0);
        HALF_STEP(pA0, pA1, mnA, alA, pB0, pB1, alB, t + 1, 0, 1, 1);
    }
    const bool even = (NT & 1) == 0;
    if (even) { SBAR(); KAUG(NT - 1, kt0, kt1); qkt<1, SK>(pB0, pB1, K_lds, r32, hi, S.qr, ACT(NT - 1), qaug, kt0, kt1); SBAR(); }
#define QROW(e) (nxt.Q + (size_t)(wid * QBLK + r32) * D + ((e) >> 1) * 16 + hi * 8 + ((e) & 1) * 4)
    if constexpr (F32) { SLOAD_F((const float*)nxt.K, kbn); SBAR();
#pragma unroll
        for (int e = 0; e < 8; ++e) S.tq[e] = *(const f32x4*)QROW(e); }
    else { SLOAD_H(nxt.K, nxt.V, kbn); SBAR();
#pragma unroll
        for (int d0 = 0; d0 < 8; ++d0) S.qr[d0] = load8<TIn>(nxt.Q + (size_t)(wid * QBLK + r32) * KVP + d0 * 16 + hi * 8); }
    SBAR();
    finishSM(pA0, pA1, alA, l_reg, pa0, pa1, pa2, pa3); SBAR();
    if constexpr (F32) {
#pragma unroll
        for (int e = 8; e < 16; ++e) S.tq[e] = *(const f32x4*)QROW(e); SBAR(); }
#undef QROW
    pv_tile<0, SK>(o, vb0, pa0, pa1, pa2, pa3, ACT(even ? NT - 2 : NT - 1));
    if (even) { MASKT(pB0, pB1, NT - 1); partialSM(pB0, pB1, m_reg, mnB, alB); __syncthreads(); RESC(alB);
        finishSM(pB0, pB1, alB, l_reg, pa0, pa1, pa2, pa3); SBAR(); pv_tile<1, SK>(o, vb0, pa0, pa1, pa2, pa3, ACT(NT - 1)); }
    SBAR(); SEAM_K0();
    if (hi == 0) li_l[r32] = l_reg; asm volatile("s_waitcnt lgkmcnt(0)" ::: "memory");
    float rli[16];
#pragma unroll
    for (int r = 0; r < 16; ++r) rli[r] = __builtin_amdgcn_rcpf(li_l[crow(r, hi)]);
    TOut* Ow = cur.O + (size_t)(wid * QBLK) * OP;
#pragma unroll
    for (int r = 0; r < 16; ++r) { const int orow = crow(r, hi);
#pragma unroll
        for (int d0 = 0; d0 < 4; ++d0) { const float v = o[d0][r] * rli[r];
            if constexpr (same_t<TOut, float>::v) { Ow[(size_t)orow * OP + d0 * 32 + r32] = v; }
            else { const float vn = __builtin_bit_cast(float, __builtin_amdgcn_update_dpp(0, __builtin_bit_cast(int, v), 0xB1, 0xF, 0xF, true));
                   if ((r32 & 1) == 0) *(unsigned*)(Ow + (size_t)orow * OP + d0 * 32 + r32) = cvtpk(v, vn); } } }
    if constexpr (F32) {
#pragma unroll
        for (int d0 = 0; d0 < 8; ++d0) S.qr[d0] = pack8(S.tq[2 * d0], S.tq[2 * d0 + 1]); }
    __syncthreads();
#undef RESC
#undef KBASE
#undef ACT
#undef MASKT
#undef SEAM_K0
#undef HALF_STEP
#undef KAUG
#undef FLOADK
}
#undef ROW
#undef VMW
#undef VMWN
#undef SLOAD_H
#undef SWRITE_HK
#undef SWRITE_HV
#undef SWRITE_H
#undef SLOAD_F
#undef SWRITE_KF
#undef SWRITE_VF

__device__ __forceinline__ void attn_phase(char* lds, const bf16* Z, bf16* Y, const float* Fs, unsigned* qhead, const int* jlo_tab, const mk::Params& prm) {
    using BR = BlockRef<bf16, bf16>;
    const int total = 1024;
    volatile int* slot = (volatile int*)(lds + 135168);
#define ATT_LBAR() do { asm volatile("s_waitcnt lgkmcnt(0)" ::: "memory"); __builtin_amdgcn_s_barrier(); asm volatile("" ::: "memory"); } while (0)
#define ATT_PULL(dst) do { if (threadIdx.x == 0) *slot = (int)atomicAdd(qhead, 1u); ATT_LBAR(); dst = __builtin_amdgcn_readfirstlane(*slot); ATT_LBAR(); } while (0)
    auto mkref = [&](int idx) { const int qb = 63 - (idx >> 4), bh = idx & 15, b = bh >> 3, h = bh & 7;
        BR r; const size_t rowb = (size_t)b * 16384;
        r.Q = Z + (rowb + (size_t)qb * QB) * KVP + h * 128; r.K = Z + rowb * KVP + 1024 + h * 128; r.V = Z + rowb * KVP + 2048 + h * 128;
        r.O = Y + (rowb + (size_t)qb * QB) * OP + h * 128; r.F = Fs + (size_t)bh * 16384; r.P0 = qb * QB; r.jlo = jlo_tab[bh * 64 + qb]; return r; };
    int ci, si = 0; ATT_PULL(ci);
    if (ci >= total) return;
    BR cur = mkref(ci);
    Seam<bf16> S;
    causal_swa_prime<bf16, bf16>(cur, 16384, lds, S);
    for (;;) {
        int ni; ATT_PULL(ni);
        const bool last = ni >= total;
        const BR nxt = last ? cur : mkref(ni);
        causal_swa_block<bf16, bf16>(cur, nxt, 16384, 16384, lds, S);
        if (last) { si = ni; break; }
        cur = nxt;
    }
    while (si < total + mk::SCAN_CHUNKS) { mk::p8_scan_chunk(prm, si - total); ATT_PULL(si); }
#undef ATT_PULL
#undef ATT_LBAR
}
}

namespace mk {
__device__ __forceinline__ void zero_y_half(bf16_t* Y, int colbase) {
    for (size_t i = (size_t)blockIdx.x * NT + threadIdx.x; i < (size_t)T * 128; i += (size_t)gridDim.x * NT) { const size_t r = i >> 7, cgp = i & 127;
        *(u32x4*)(Y + r * DM + colbase + 8 * cgp) = (u32x4){0u, 0u, 0u, 0u}; }
}
__device__ __forceinline__ void dump_cst(const bf16_t* C, const float* nstp, bf16_t* Y) {
    for (size_t i = (size_t)blockIdx.x * NT + threadIdx.x; i < (size_t)T * 1024; i += (size_t)gridDim.x * NT) { const size_t r = i >> 10, c = i & 1023;
        const float v = 1e-3f * (bf2f(C[r * 2048 + c]) + bf2f(C[r * 2048 + 1024 + c])) + 1e-3f * nstp[i & 262143];
        Y[r * DM + 1024 + c] = (bf16_t)(pk2(v, 0.f) & 0xffffu); }
}
__global__ void __launch_bounds__(NT, 2) mega(Params p) {
    extern __shared__ __attribute__((aligned(16))) unsigned char lds_raw[];
    LAS unsigned char* lds = (LAS unsigned char*)lds_raw;
    cg::grid_group grid = cg::this_grid();
#ifdef PROBE_A
    LAS unsigned* stamps = (LAS unsigned*)(lds + 147200); int sk = 0;
#define STAMP() do { if (blockIdx.x == 0 && threadIdx.x == 0) stamps[sk] = (unsigned)__builtin_amdgcn_s_memrealtime(); ++sk; } while (0)
#else
#define STAMP() do { } while (0)
#endif
    STAMP();
#define GRID_SYNC_CG() do { asm volatile("s_waitcnt vmcnt(0) lgkmcnt(0)" ::: "memory"); grid.sync(); STAMP(); } while (0)
    LAS unsigned* xst = (LAS unsigned*)(lds + 147440);
    if (threadIdx.x < 4) xst[threadIdx.x] = 0u;
    __syncthreads();
    XcdBarrier xbar; xbar.bar = (unsigned*)(p.ws + WS_BAR); xbar.x = 0u; xbar.st = (volatile LAS unsigned*)xst;
    if (blockIdx.x == 0) for (int i_ = threadIdx.x; i_ < XCD_BAR_WORDS; i_ += NT) ((unsigned*)(p.ws + WS_BAR))[i_] = 0u;
#define GRID_SYNC() do { xcd_barrier(xbar); STAMP(); } while (0)
    unsigned char* ws = p.ws;
    float* ada = (float*)(ws + WS_ADA);
    bf16_t* A = (bf16_t*)(ws + WS_A); bf16_t* ZH = (bf16_t*)(ws + WS_Z); bf16_t* R = (bf16_t*)(ws + WS_R);
    const int G = gridDim.x; int c = blockIdx.x;

#ifdef DUP_SYNC
    for (int i_ = 0; i_ < 10; ++i_) GRID_SYNC();
#endif
    p0_prologue(p, lds);
#ifdef DUP_P0
    GRID_SYNC();
    p0_prologue(p, lds);
#endif
    GRID_SYNC_CG();
    xbar = xcd_barrier_post((unsigned*)(p.ws + WS_BAR), (volatile LAS unsigned*)xst);
    if (threadIdx.x == 0) { const unsigned rk = atomicAdd((unsigned*)(ws + WS_CTRL) + 8 + (xbar.x & 7u), 1u); xst[2] = (xbar.x & 7u) + 8u * rk; }
    ln_phase<0>(p.x, nullptr, A, nullptr, nullptr, ada + 0 * DM, ada + 1 * DM, nullptr);
#ifdef DUP_LN0
    GRID_SYNC();
    ln_phase<0>(p.x, nullptr, A, nullptr, nullptr, ada + 0 * DM, ada + 1 * DM, nullptr);
#endif
    GRID_SYNC();
    { bool okx = (G % 8) == 0;
      for (int j = 0; j < 8; ++j) okx = okx && (__hip_atomic_load((unsigned*)(ws + WS_CTRL) + 8 + j, __ATOMIC_RELAXED, __HIP_MEMORY_SCOPE_AGENT) == (unsigned)(G / 8));
      if (okx) c = (int)__builtin_amdgcn_readfirstlane(xst[2]); }
    { pg8::Gemm g{A, (const bf16_t*)(ws + WS_W1T), T, 2 * DFF, DM}; pg8::StaticOrder S; S.init(T, 2 * DFF, G, c);
      pg8::EpiSwiglu E{ZH, DFF}; pg8::gemm_phase<pg8::EpiSwiglu, pg8::StaticOrder, true, true>(lds, g, S, E);
#ifdef DUP_G1
      GRID_SYNC(); pg8::gemm_phase<pg8::EpiSwiglu, pg8::StaticOrder, true, true>(lds, g, S, E);
#endif
    }
    GRID_SYNC();
    { pg8::Gemm g{ZH, (const bf16_t*)(ws + WS_W1O), T, DM, DFF}; pg8::StaticOrder S; S.init(T, DM, G, c);
      pg8::EpiResid E{p.x, nullptr, R, ada + 2 * DM, ALPHA, 0.5f, SEQ, NADA, nullptr, nullptr, nullptr}; pg8::gemm_phase<pg8::EpiResid, pg8::StaticOrder, true, true>(lds, g, S, E); }
    GRID_SYNC();
    ln_phase<1>(R, nullptr, A, p.ln1_g, p.ln1_b, ada + 3 * DM, ada + 4 * DM, (float*)(ws + WS_STATS));
    GRID_SYNC();
#ifndef SKIP_MIXER
    { pg8::Gemm g{A, (const bf16_t*)(ws + WS_WIN), T, NINP, DM}; pg8::StaticOrder S; S.init(T, NINP, G, c);
      pg8::EpiInproj E{ZH, (float*)(ws + WS_GATES), p.fox_fb, p.ml_ib, p.ml_fb}; pg8::gemm_phase<pg8::EpiInproj, pg8::StaticOrder, true, true>(lds, g, S, E); }
    GRID_SYNC();
    p6_scalars_conv(p, lds);
#ifdef DUP_P6
    GRID_SYNC();
    p6_scalars_conv(p, lds);
#endif
    GRID_SYNC();
#ifndef SKIP_MLSTM
    p7_mlstm_local(p, lds);
#ifdef DUP_P7
    GRID_SYNC();
    p7_mlstm_local(p, lds);
#endif
    GRID_SYNC();
#endif
#ifndef SKIP_ATTN
    fa::attn_phase((char*)lds_raw, (const fa::bf16*)ZH, (fa::bf16*)A, (const float*)(ws + WS_FS), (unsigned*)(ws + WS_CTRL), (const int*)(ws + WS_CTRL + 1024), p);
#ifdef DUP_ATTN
    GRID_SYNC();
    fa::attn_phase((char*)lds_raw, (const fa::bf16*)ZH, (fa::bf16*)A, (const float*)(ws + WS_FS), (unsigned*)(ws + WS_CTRL), (const int*)(ws + WS_CTRL + 1024), p);
#endif
#else
    zero_y_half(A, 0);
#endif
    GRID_SYNC();
#if defined(DUMP_CST)
    dump_cst((const bf16_t*)(ws + WS_CST), (const float*)(ws + WS_NST), A);
#elif !defined(SKIP_MLSTM)
    p9_mlstm_out(p, lds);
#ifdef DUP_P9
    GRID_SYNC();
    p9_mlstm_out(p, lds);
#endif
#else
    zero_y_half(A, 1024);
#endif
    GRID_SYNC();
    { pg8::Gemm g{A, (const bf16_t*)(ws + WS_WOT), T, DM, DM}; pg8::StaticOrder S; S.init(T, DM, G, c);
      pg8::EpiResid E{nullptr, R, R, ada + 5 * DM, ALPHA, 1.0f, SEQ, NADA, (const float*)(ws + WS_STATS), p.ln1_g, p.ln1_b}; pg8::gemm_phase<pg8::EpiResid, pg8::StaticOrder, true, true>(lds, g, S, E); }
    GRID_SYNC();
#endif
    ln_phase<1>(R, nullptr, A, p.ln2_g, p.ln2_b, ada + 6 * DM, ada + 7 * DM, (float*)(ws + WS_STATS) + 2 * T);
    GRID_SYNC();
    { pg8::Gemm g{A, (const bf16_t*)(ws + WS_W2T), T, 2 * DFF, DM}; pg8::StaticOrder S; S.init(T, 2 * DFF, G, c);
      pg8::EpiSwiglu E{ZH, DFF}; pg8::gemm_phase<pg8::EpiSwiglu, pg8::StaticOrder, true, true>(lds, g, S, E); }
    GRID_SYNC();
    { pg8::Gemm g{ZH, (const bf16_t*)(ws + WS_W2O), T, DM, DFF}; pg8::StaticOrder S; S.init(T, DM, G, c);
      pg8::EpiResid E{nullptr, R, R, ada + 8 * DM, ALPHA, 0.5f, SEQ, NADA, (const float*)(ws + WS_STATS) + 2 * T, p.ln2_g, p.ln2_b}; pg8::gemm_phase<pg8::EpiResid, pg8::StaticOrder, true, true>(lds, g, S, E); }
    GRID_SYNC();
    ln_phase<2>(R, p.out, nullptr, p.ln3_g, p.ln3_b, nullptr, nullptr, nullptr);
#ifdef PROBE_A
    STAMP();
    asm volatile("s_waitcnt vmcnt(0) lgkmcnt(0)" ::: "memory"); __syncthreads();
    if (blockIdx.x == 0) {
        const float tA = (float)(stamps[PROBE_A + 1] - stamps[PROBE_A]) * 1e-5f, tB = (float)(stamps[PROBE_B + 1] - stamps[PROBE_B]) * 1e-5f;
        for (int i = threadIdx.x; i < 128 * DM; i += NT) { const int r = (i >> 11), cc = i & (DM - 1); const int row = (r & 7) + (r >> 3) * (gridDim.x * NWV);
            atomicAdd(p.out + (size_t)row * DM + cc, 16.0f * tB + ((row == 0 && cc == 0) ? 1000.0f * tA : 0.f)); }
    }
#endif
}
}

extern "C" void kernel_launch(void* const* d_in, const int* in_sizes, int n_in, void* d_out, int out_size, void* d_ws, size_t ws_size, hipStream_t stream) {
    static int grid = 0;
    if (grid == 0) {
        if (n_in != 22 || in_sizes[0] != mk::T * mk::DM || out_size != mk::T * mk::DM || ws_size < mk::WS_END) {
            fprintf(stderr, "kernel_launch: unexpected shapes (n_in %d, in0 %d, out %d, ws %zu)\n", n_in, n_in > 0 ? in_sizes[0] : -1, out_size, ws_size); grid = -1; return; }
        int dev = 0, cus = 0, per_cu = 0;
        (void)hipGetDevice(&dev); (void)hipDeviceGetAttribute(&cus, hipDeviceAttributeMultiprocessorCount, dev);
        if (hipFuncSetAttribute((const void*)mk::mega, hipFuncAttributeMaxDynamicSharedMemorySize, mk::LDS_BYTES) != hipSuccess) { fprintf(stderr, "kernel_launch: hipFuncSetAttribute failed\n"); grid = -1; return; }
        if (hipOccupancyMaxActiveBlocksPerMultiprocessor(&per_cu, (const void*)mk::mega, mk::NT, mk::LDS_BYTES) != hipSuccess || per_cu < 1) { fprintf(stderr, "kernel_launch: occupancy query says %d\n", per_cu); per_cu = 1; }
        (void)hipGetLastError();
        if (cus <= 0) cus = 256;
        grid = cus;
    }
    if (grid < 0) return;
    mk::Params p{};
    const float** pp = (const float**)&p;
    for (int i = 0; i < 22; ++i) pp[i] = (const float*)d_in[i];
    p.out = (float*)d_out; p.ws = (unsigned char*)d_ws;
    void* args[] = {&p};
    hipError_t e = hipLaunchCooperativeKernel((const void*)mk::mega, dim3(grid), dim3(mk::NT), args, mk::LDS_BYTES, stream);
    if (e != hipSuccess) fprintf(stderr, "kernel_launch: cooperative launch failed: %s (grid %d)\n", hipGetErrorString(e), grid);
}
```
